# Optimizing an MI355X kernel written in HIP

```python
import jax, jax.numpy as jnp
from jax import lax
import numpy as np

D_MODEL = 1024
BATCH = 32
SEQ = 256
DEPTH = 2
DEC_BATCH = 8
DEC_SEQ = 1024
PAST_LEN = 256

GRID_W = 64
POOL_WIDTH = 256
POOL_GROUPS = 4
POOL_GROUP_DIM = POOL_WIDTH // POOL_GROUPS
POOL_WINDOWS = (2, 4, 8, 16)
NA_HEADS = 8
HEAD_DIM = 64
NA_WIDTH = NA_HEADS * HEAD_DIM
NA_ROWS_MAX = 8
NA_COLS = 16
SG_WIDTH = 256
SG_GROUPS = 4
SG_GROUP_DIM = SG_WIDTH // SG_GROUPS
CHUNK = 128
D_FF = 2816
N_MOD = 9
MIX_WIDTH = POOL_WIDTH + NA_WIDTH + SG_WIDTH
IN_WIDTH = POOL_WIDTH + 3 * NA_WIDTH + 2 * SG_WIDTH
IN_SPLITS = (POOL_WIDTH, POOL_WIDTH + NA_WIDTH, POOL_WIDTH + 2 * NA_WIDTH,
             POOL_WIDTH + 3 * NA_WIDTH, POOL_WIDTH + 3 * NA_WIDTH + SG_WIDTH)
EPS = 1e-6

kernel_name = "hybrid_pool_natten_sgmlp_diffusion_step"


def _rms(x, g):
    x32 = x.astype(jnp.float32)
    y = x32 * lax.rsqrt(jnp.mean(x32 * x32, axis=-1, keepdims=True) + EPS)
    return y.astype(x.dtype) * g


def _modulate(h, shift, scale):
    return h * (1.0 + scale) + shift


def _swiglu(h, w_gate, w_up, w_down):
    return (jax.nn.silu(h @ w_gate) * (h @ w_up)) @ w_down


def _half_ffn(x, gain, shift, scale, gate, w_gate, w_up, w_down):
    return x + 0.5 * gate * _swiglu(_modulate(_rms(x, gain), shift, scale), w_gate, w_up, w_down)


def _heads(x):
    b, l, _ = x.shape
    return x.reshape(b, l, NA_HEADS, HEAD_DIM).transpose(0, 2, 1, 3)


def _pool_mixer(a, w_pool, pool_scale):
    b, l, _ = a.shape
    a32 = a.astype(jnp.float32)
    csum = jnp.concatenate([jnp.zeros_like(a32[:, :1]), jnp.cumsum(a32, axis=1)], axis=1)
    t = jnp.arange(l)
    outs = []
    for gi, w in enumerate(POOL_WINDOWS):
        lo = jnp.clip(t - w // 2, 0, l)
        hi = jnp.clip(t + w // 2, 0, l)
        cg = csum[..., gi * POOL_GROUP_DIM:(gi + 1) * POOL_GROUP_DIM]
        cnt = (hi - lo).astype(jnp.float32)[None, :, None]
        outs.append((cg[:, hi] - cg[:, lo]) / cnt)
    pooled = jnp.concatenate(outs, axis=-1).astype(a.dtype) - a
    pooled = pooled.reshape(b, l, POOL_GROUPS, POOL_GROUP_DIM)
    mixed = jnp.einsum('blgc,gcd->blgd', pooled, w_pool).reshape(b, l, POOL_WIDTH)
    return mixed * pool_scale


def _chunk_mixer(u, v, vnorm_g, w_s, b_s):
    b, l, _ = u.shape
    n = l // CHUNK
    u = jax.nn.gelu(u)
    vg = _rms(jax.nn.gelu(v).reshape(b, n, CHUNK, SG_GROUPS, SG_GROUP_DIM), vnorm_g)
    sp = jnp.einsum('gpq,bnqgc->bnpgc', w_s, vg) + b_s.T[:, :, None]
    return u * sp.reshape(b, l, SG_WIDTH)


def _context_attention(q, k, v):
    b, h, lc, d = q.shape
    nb = lc // CHUNK
    scale = d ** -0.5
    qb = q.reshape(b, h, nb, CHUNK, d).transpose(2, 0, 1, 3, 4)

    def block(qi):
        s = jnp.einsum('bhqd,bhkd->bhqk', qi, k).astype(jnp.float32) * scale
        p = jax.nn.softmax(s, axis=-1).astype(v.dtype)
        return jnp.einsum('bhqk,bhkd->bhqd', p, v)

    o = lax.map(block, qb)
    return o.transpose(1, 2, 0, 3, 4).reshape(b, h, lc, d)


def _neighbourhood_attention(q, k, v, k_ctx, v_ctx, rpb):
    b, h, l, d = q.shape
    rows = l // GRID_W
    kh = min(NA_ROWS_MAX, rows)
    scale = d ** -0.5
    kg = k.reshape(b, h, rows, GRID_W, d)
    vg = v.reshape(b, h, rows, GRID_W, d)
    qg = q.reshape(b, h, rows, GRID_W, d).transpose(2, 0, 1, 3, 4)
    cols = jnp.arange(GRID_W)
    col_start = jnp.clip(cols - NA_COLS // 2, 0, GRID_W - NA_COLS)
    col_ok = (cols[None, :] >= col_start[:, None]) & (cols[None, :] < col_start[:, None] + NA_COLS)
    dc_idx = jnp.clip(cols[None, :] - cols[:, None], -(NA_COLS - 1), NA_COLS - 1) + (NA_COLS - 1)

    def row_block(args):
        r, q_r = args
        start = jnp.clip(r - kh // 2, 0, rows - kh)
        k_r = lax.dynamic_slice_in_dim(kg, start, kh, axis=2)
        v_r = lax.dynamic_slice_in_dim(vg, start, kh, axis=2)
        dr_idx = start + jnp.arange(kh) - r + (NA_ROWS_MAX - 1)
        bias = rpb[:, dr_idx][:, :, dc_idx].transpose(0, 2, 1, 3)
        s_loc = jnp.einsum('bhqd,bhkwd->bhqkw', q_r, k_r).astype(jnp.float32) * scale
        s_loc = jnp.where(col_ok[:, None, :], s_loc + bias[None].astype(jnp.float32), -jnp.inf)
        s_ctx = jnp.einsum('bhqd,bhcd->bhqc', q_r, k_ctx).astype(jnp.float32) * scale
        s = jnp.concatenate([s_loc.reshape(b, h, GRID_W, kh * GRID_W), s_ctx], axis=-1)
        p = jax.nn.softmax(s, axis=-1).astype(v.dtype)
        p_loc = p[..., :kh * GRID_W].reshape(b, h, GRID_W, kh, GRID_W)
        p_ctx = p[..., kh * GRID_W:]
        return (jnp.einsum('bhqkw,bhkwd->bhqd', p_loc, v_r)
                + jnp.einsum('bhqc,bhcd->bhqd', p_ctx, v_ctx))

    o = lax.map(row_block, (jnp.arange(rows), qg))
    return o.transpose(1, 2, 0, 3, 4).reshape(b, h, l, d)


def _mixer_inputs(h, w_in, q_norm_g, k_norm_g):
    z = h @ w_in
    za, zq, zk, zv, zu, zsv = jnp.split(z, IN_SPLITS, axis=-1)
    q = _rms(_heads(zq), q_norm_g)
    k = _rms(_heads(zk), k_norm_g)
    return za, q, k, _heads(zv), zu, zsv


def _mixer_output(a_out, attn_out, sg_out, out_norm_g, w_out):
    b, h, l, d = attn_out.shape
    o_b = attn_out.transpose(0, 2, 1, 3).reshape(b, l, NA_WIDTH)
    g_a, g_b, g_c = jnp.split(out_norm_g, [POOL_WIDTH, POOL_WIDTH + NA_WIDTH])
    o = jnp.concatenate([_rms(a_out, g_a), _rms(o_b, g_b), _rms(sg_out, g_c)], axis=-1)
    return o @ w_out


def setup_inputs(seed: int = 0) -> dict:
    key = jax.random.key(seed)
    ks = jax.random.split(key, 24)

    def nrm(k, shape, scale):
        return jax.random.normal(k, shape, jnp.float32) * scale

    return {
        "x_prompt": nrm(ks[0], (BATCH, SEQ, D_MODEL), 1.0),
        "x_sample": nrm(ks[1], (DEC_BATCH, DEC_SEQ, D_MODEL), 1.0),
        "cache_k": nrm(ks[2], (DEC_BATCH, DEPTH, NA_HEADS, PAST_LEN, HEAD_DIM), 1.0),
        "cache_v": nrm(ks[3], (DEC_BATCH, DEPTH, NA_HEADS, PAST_LEN, HEAD_DIM), 1.0),
        "c": nrm(ks[4], (DEC_BATCH, D_MODEL), 1.0),
        "c_ctx": nrm(ks[5], (D_MODEL,), 1.0),
        "ada_w": nrm(ks[6], (DEPTH, D_MODEL, N_MOD * D_MODEL), 0.5 * D_MODEL ** -0.5),
        "ada_b": nrm(ks[7], (DEPTH, N_MOD * D_MODEL), 0.02),
        "norm_g": 1.0 + nrm(ks[8], (DEPTH, 3, D_MODEL), 0.05),
        "ffn_w_gate": nrm(ks[9], (DEPTH, 2, D_MODEL, D_FF), D_MODEL ** -0.5),
        "ffn_w_up": nrm(ks[10], (DEPTH, 2, D_MODEL, D_FF), D_MODEL ** -0.5),
        "ffn_w_down": nrm(ks[11], (DEPTH, 2, D_FF, D_MODEL), D_FF ** -0.5),
        "w_in": nrm(ks[12], (DEPTH, D_MODEL, IN_WIDTH), D_MODEL ** -0.5),
        "pool_w": nrm(ks[13], (DEPTH, POOL_GROUPS, POOL_GROUP_DIM, POOL_GROUP_DIM), POOL_GROUP_DIM ** -0.5),
        "pool_scale": 1.0 + nrm(ks[14], (DEPTH, POOL_WIDTH), 0.05),
        "q_norm_g": 1.0 + nrm(ks[15], (DEPTH, HEAD_DIM), 0.05),
        "k_norm_g": 1.0 + nrm(ks[16], (DEPTH, HEAD_DIM), 0.05),
        "na_rpb": nrm(ks[17], (DEPTH, NA_HEADS, 2 * NA_ROWS_MAX - 1, 2 * NA_COLS - 1), 0.1),
        "sg_vnorm_g": 1.0 + nrm(ks[18], (DEPTH, SG_GROUPS, SG_GROUP_DIM), 0.05),
        "sg_w": nrm(ks[19], (DEPTH, SG_GROUPS, CHUNK, CHUNK), CHUNK ** -0.5),
        "sg_b": 1.0 + nrm(ks[20], (DEPTH, SG_GROUPS, CHUNK), 0.05),
        "out_norm_g": 1.0 + nrm(ks[21], (DEPTH, MIX_WIDTH), 0.05),
        "w_out": nrm(ks[22], (DEPTH, MIX_WIDTH, D_MODEL), MIX_WIDTH ** -0.5),
    }


def reference(x_prompt, x_sample, cache_k, cache_v, c, c_ctx, ada_w, ada_b, norm_g,
              ffn_w_gate, ffn_w_up, ffn_w_down, w_in, pool_w, pool_scale, q_norm_g,
              k_norm_g, na_rpb, sg_vnorm_g, sg_w, sg_b, out_norm_g, w_out):
    xp = x_prompt
    xs = x_sample
    ctx_k = []
    ctx_v = []
    for l in range(DEPTH):
        mc = (jax.nn.silu(c_ctx) @ ada_w[l] + ada_b[l]).reshape(N_MOD, D_MODEL)
        ml_all = (jax.nn.silu(c) @ ada_w[l] + ada_b[l]).reshape(c.shape[0], 1, N_MOD, D_MODEL)
        ml = [ml_all[:, :, i] for i in range(N_MOD)]

        xp = _half_ffn(xp, norm_g[l, 0], mc[0], mc[1], mc[2],
                       ffn_w_gate[l, 0], ffn_w_up[l, 0], ffn_w_down[l, 0])
        h = _modulate(_rms(xp, norm_g[l, 1]), mc[3], mc[4])
        za, q, k, v, zu, zsv = _mixer_inputs(h, w_in[l], q_norm_g[l], k_norm_g[l])
        ctx_k.append(k)
        ctx_v.append(v)
        o = _mixer_output(_pool_mixer(za, pool_w[l], pool_scale[l]),
                          _context_attention(q, k, v),
                          _chunk_mixer(zu, zsv, sg_vnorm_g[l], sg_w[l], sg_b[l]),
                          out_norm_g[l], w_out[l])
        xp = xp + mc[5] * o
        xp = _half_ffn(xp, norm_g[l, 2], mc[6], mc[7], mc[8],
                       ffn_w_gate[l, 1], ffn_w_up[l, 1], ffn_w_down[l, 1])

        xs = _half_ffn(xs, norm_g[l, 0], ml[0], ml[1], ml[2],
                       ffn_w_gate[l, 0], ffn_w_up[l, 0], ffn_w_down[l, 0])
        h = _modulate(_rms(xs, norm_g[l, 1]), ml[3], ml[4])
        za, q, k, v, zu, zsv = _mixer_inputs(h, w_in[l], q_norm_g[l], k_norm_g[l])
        o = _mixer_output(_pool_mixer(za, pool_w[l], pool_scale[l]),
                          _neighbourhood_attention(q, k, v, cache_k[:, l], cache_v[:, l], na_rpb[l]),
                          _chunk_mixer(zu, zsv, sg_vnorm_g[l], sg_w[l], sg_b[l]),
                          out_norm_g[l], w_out[l])
        xs = xs + ml[5] * o
        xs = _half_ffn(xs, norm_g[l, 2], ml[6], ml[7], ml[8],
                       ffn_w_gate[l, 1], ffn_w_up[l, 1], ffn_w_down[l, 1])

    new_k = jnp.stack(ctx_k, axis=1)
    new_v = jnp.stack(ctx_v, axis=1)
    return (xp, xs, new_k, new_v)
```

```cpp
#include <hip/hip_runtime.h>
#include <hip/hip_cooperative_groups.h>
#include <cstdio>
#include <cstdint>
namespace cg = cooperative_groups;

#define PROBE_REP 0
#define PROBE_SYNC 0
#define PROBE_MIX 0

#define LAS __attribute__((address_space(3)))
typedef unsigned short bf16_t;
typedef short bf16x8 __attribute__((ext_vector_type(8)));
typedef short s16x4 __attribute__((ext_vector_type(4)));
typedef float f32x4 __attribute__((ext_vector_type(4)));
typedef float f32x2 __attribute__((ext_vector_type(2)));
typedef float f32x16 __attribute__((ext_vector_type(16)));
typedef unsigned u32x4 __attribute__((ext_vector_type(4)));
typedef unsigned u32x2 __attribute__((ext_vector_type(2)));

constexpr int M = 16384, MCTX = 8192, D = 1024, FF = 2816, NGU = 2 * FF, NIN = 2304, NMOD = 9;
constexpr int NK_OFF = 16777216, NV_OFF = 25165824;
constexpr float EPS = 1e-6f;
constexpr float LOG2E = 1.4426950408889634f;

constexpr size_t MiB = 1u << 20;
constexpr size_t WS_MOD = 0;
constexpr size_t WS_CTL = 1 * MiB + 512 * 1024, CTL_BYTES = 16384;
constexpr size_t WS_PW = 1 * MiB + 256 * 1024;
constexpr size_t WS_SW = 1 * MiB;
constexpr size_t WS_CK = 2 * MiB;
constexpr size_t WS_CVT = 6 * MiB;
constexpr size_t WS_SSP = 10 * MiB;
constexpr size_t WS_BIAS = 11 * MiB;
constexpr size_t WS_SHB = 12 * MiB;
constexpr int NB = 13568;
constexpr size_t WS_W = 16 * MiB;
constexpr size_t W_GU_SZ = (size_t)NGU * D * 2, W_IN_SZ = (size_t)NIN * D * 2, W_D_SZ = (size_t)D * FF * 2, W_OUT_SZ = (size_t)D * D * 2;
constexpr size_t W_GU0 = 0, W_IN = W_GU_SZ, W_GU1 = W_IN + W_IN_SZ, W_D = W_GU1 + W_GU_SZ, W_OUT = W_D + 2 * W_D_SZ;
constexpr size_t W_LAYER = W_OUT + W_OUT_SZ;
constexpr size_t WS_H = 96 * MiB;
constexpr size_t WS_ACT = 128 * MiB;
constexpr size_t WS_ZA = 128 * MiB;
constexpr size_t WS_UT = 136 * MiB;
constexpr size_t WS_VGT = 144 * MiB;
constexpr size_t WS_Q = 152 * MiB;
constexpr size_t WS_K = 168 * MiB;
constexpr size_t WS_VT = 184 * MiB;
constexpr size_t WS_OB = 200 * MiB;
constexpr size_t WS_XB = 232 * MiB;
static_assert(WS_W + 2 * W_LAYER <= WS_H, "weights fit");

struct Params {
    const float *x_prompt, *x_sample, *cache_k, *cache_v, *c, *c_ctx, *ada_w, *ada_b, *norm_g;
    const float *w_gate, *w_up, *w_down, *w_in, *pool_w, *pool_scale, *q_norm_g, *k_norm_g, *na_rpb;
    const float *sg_vnorm_g, *sg_w, *sg_b, *out_norm_g, *w_out;
    float* out; unsigned char* ws;
    int ph_lo, ph_hi;
};

typedef __bf16 hbf16x2 __attribute__((ext_vector_type(2)));
__device__ __forceinline__ unsigned pk2(float lo, float hi) { const f32x2 v = {lo, hi}; const hbf16x2 b = __builtin_convertvector(v, hbf16x2); return __builtin_bit_cast(unsigned, b); }
__device__ __forceinline__ unsigned f2bf(float f) { return pk2(f, 0.f) & 0xffffu; }
typedef const __attribute__((address_space(4))) Params* KargPtr;
struct ECtx { KargPtr kp; int l, k; LAS unsigned char* lds_epi_; };
__device__ __forceinline__ float bf2f(unsigned short b) { return __builtin_bit_cast(float, (unsigned)b << 16); }
__device__ __forceinline__ float wave_sum(float v) {
#pragma unroll
    for (int o = 1; o < 64; o <<= 1) v += __shfl_xor(v, o);
    return v;
}
__device__ __forceinline__ float fast_sigmoid(float x) { return __builtin_amdgcn_rcpf(1.0f + __builtin_amdgcn_exp2f(-x * LOG2E)); }
__device__ __forceinline__ float silu_f(float x) { return x * fast_sigmoid(x); }
__device__ __forceinline__ float gelu_tanh(float x) { const float y = 0.7978845608028654f * (x + 0.044715f * x * x * x); return x * fast_sigmoid(2.0f * y); }
__device__ __forceinline__ int kind_of_row(int row) { return row < MCTX ? 0 : 1 + ((row - MCTX) >> 10); }

namespace pg8 {
constexpr int BM = 256, BK = 64, HALF = 128, HTB = HALF * BK * 2, STAGE_BYTES = 8 * HTB, NXCD = 8, WGM = 8;
__host__ __device__ __forceinline__ int lds_byte(int r, int c) { const int st = (r >> 4) * 2 + (c >> 5), rr = r & 15, cc = c & 31, ob = rr * 64 + cc * 2; return st * 1024 + (ob ^ (((ob >> 9) & 1) << 5)); }
__host__ __device__ __forceinline__ void stage_rc(int b, int& R, int& C) { const int st = b / 1024, sb = b % 1024, swz = sb ^ (((sb >> 9) & 1) << 5); R = (st >> 1) * 16 + swz / 64; C = (st & 1) * 32 + (swz % 64) / 2; }
struct Unit { int pm, pn; };
struct Gemm { const bf16_t* A; const bf16_t* Bt; int M, N, K; };
struct StaticOrder {
    int nM, nN, nwg, G, c; int exi, expm, expn;
    __device__ void init(int M_, int N_, int G_, int c_) { nM = M_ / BM; nN = N_ / BM; nwg = nM * nN; G = G_; c = c_; exi = -1; expm = 0; expn = 0; }
    __device__ bool next(int i, Unit& u) const {
        const long L = (long)i * G + c; if (L >= nwg) { if (i == exi) { u.pm = expm; u.pn = expn; return true; } return false; }
        int wgid = (int)L; { const int q = nwg / NXCD, r = nwg % NXCD, xcd = wgid % NXCD, off = wgid / NXCD; wgid = (xcd < r ? xcd * (q + 1) : r * (q + 1) + (xcd - r) * q) + off; }
        const int nig = WGM * nN, gid = wgid / nig, fm = gid * WGM, gsz = (nM - fm) < WGM ? (nM - fm) : WGM;
        u.pm = fm + ((wgid % nig) % gsz); u.pn = (wgid % nig) / gsz;
        if (nN == 9) u.pn = u.pn == 8 ? 0 : u.pn + 1;
        return true;
    }
};
template <class Epi>
__device__ __forceinline__ void gemm_phase(LAS unsigned char* lds, const int tid, const Gemm g, const StaticOrder& S, const Epi& E) {
    const int wid = __builtin_amdgcn_readfirstlane(tid >> 6), lane = tid & 63, wr = wid >> 2, wc = wid & 3, fr = lane & 15, fq = lane >> 4;
    const int K = g.K, nt = K / BK;
    unsigned voffA[2];
#pragma unroll
    for (int i = 0; i < 2; ++i) { int R, C; stage_rc(tid * 16 + i * 8192, R, C); voffA[i] = (unsigned)(R * K + C) * 2u; }
    const size_t kstep = (size_t)(BK * 2);
    const size_t hstep = (size_t)HALF * K * 2;
    const size_t tstep = 2 * hstep;
    const unsigned ldsw = (unsigned)wid * 1024u;
    const int aoff = lds_byte(wr * 64 + fr, fq * 8), boff = lds_byte(wc * 32 + fr, fq * 8);
#define PG8_SA(b, h) (((b) * 2 + (h)) * HTB)
#define PG8_SB(b, h) ((4 + (b) * 2 + (h)) * HTB)
#define PG8_STAGE(bufoff, gbase) do { _Pragma("unroll") for (int _i = 0; _i < 2; ++_i) \
        __builtin_amdgcn_global_load_lds((const unsigned*)((const char*)(gbase) + voffA[_i]), (LAS unsigned*)(lds + (bufoff) + ldsw + _i * 8192), 16, 0, 0); } while (0)
#define PG8_LDA(dst, b, h) do { _Pragma("unroll") for (int m = 0; m < 4; ++m) _Pragma("unroll") for (int k = 0; k < 2; ++k) dst[m][k] = *(const LAS bf16x8*)(lds + PG8_SA(b, h) + aoff + m * 2048 + k * 1024); } while (0)
#define PG8_LDB(dst, b, h) do { _Pragma("unroll") for (int n = 0; n < 2; ++n) _Pragma("unroll") for (int k = 0; k < 2; ++k) dst[n][k] = *(const LAS bf16x8*)(lds + PG8_SB(b, h) + boff + n * 2048 + k * 1024); } while (0)
#define PG8_MMA(ai, bj, At, Bt) do { __builtin_amdgcn_s_setprio(1); _Pragma("unroll") for (int m = 0; m < 4; ++m) _Pragma("unroll") for (int n = 0; n < 2; ++n) _Pragma("unroll") for (int k = 0; k < 2; ++k) \
        acc[ai][bj][m][n] = __builtin_amdgcn_mfma_f32_16x16x32_bf16(Bt[n][k], At[m][k], acc[ai][bj][m][n], 0, 0, 0); __builtin_amdgcn_s_setprio(0); } while (0)
#define PG8_WAIT_V(n) asm volatile("s_waitcnt vmcnt(" #n ")" ::: "memory")
#define PG8_WAIT_L(n) asm volatile("s_waitcnt lgkmcnt(" #n ")" ::: "memory")
#define PG8_BAR __builtin_amdgcn_s_barrier()
#define PG8_SCHED __builtin_amdgcn_sched_barrier(0)
    Unit cur, nxt; int ui = 0;
    if (!S.next(0, cur)) return;
    f32x4 acc[2][2][4][2];
#pragma unroll
    for (int a = 0; a < 2; ++a)
#pragma unroll
        for (int b = 0; b < 2; ++b)
#pragma unroll
            for (int m = 0; m < 4; ++m)
#pragma unroll
                for (int n = 0; n < 2; ++n) acc[a][b][m][n] = (f32x4){0.f, 0.f, 0.f, 0.f};
    bf16x8 At[4][2], B0[2][2], B1[2][2];
    const char* cA = (const char*)g.A + (size_t)cur.pm * tstep; const char* cB = (const char*)g.Bt + (size_t)cur.pn * tstep;
    PG8_STAGE(PG8_SB(0, 0), cB); PG8_STAGE(PG8_SB(0, 1), cB + hstep); PG8_STAGE(PG8_SA(0, 0), cA); PG8_STAGE(PG8_SA(0, 1), cA + hstep);
    if (wr == 1) PG8_BAR;
    PG8_WAIT_V(2); PG8_BAR;
    PG8_STAGE(PG8_SB(1, 0), cB + kstep); PG8_STAGE(PG8_SA(1, 0), cA + kstep); PG8_STAGE(PG8_SB(1, 1), cB + hstep + kstep);
    PG8_WAIT_V(6); PG8_BAR;
    for (;;) {
        const bool has_next = S.next(ui + 1, nxt);
        const char* nA = has_next ? (const char*)g.A + (size_t)nxt.pm * tstep : cA; const char* nB = has_next ? (const char*)g.Bt + (size_t)nxt.pn * tstep : cB;
        for (int t = 0; t < nt; t += 2) {
            const bool last = (t == nt - 2);
            const char* a1 = cA + (size_t)(t + 1) * kstep;
            const char* a2 = last ? nA : cA + (size_t)(t + 2) * kstep; const char* b2 = last ? nB : cB + (size_t)(t + 2) * kstep;
            const char* a3 = a2 + kstep; const char* b3 = b2 + kstep;
            PG8_LDB(B0, 0, 0); PG8_LDB(B1, 0, 1); PG8_SCHED; PG8_LDA(At, 0, 0); PG8_STAGE(PG8_SA(1, 1), a1 + hstep);
            PG8_WAIT_V(8); PG8_WAIT_L(0); PG8_BAR; PG8_MMA(0, 0, At, B0); PG8_MMA(0, 1, At, B1); PG8_BAR; PG8_SCHED;
            PG8_LDA(At, 0, 1); PG8_STAGE(PG8_SB(0, 0), b2); PG8_STAGE(PG8_SB(0, 1), b2 + hstep); PG8_STAGE(PG8_SA(0, 0), a2);
            PG8_WAIT_V(8); PG8_WAIT_L(0); PG8_BAR; PG8_MMA(1, 0, At, B0); PG8_MMA(1, 1, At, B1); PG8_BAR; PG8_SCHED;
            PG8_LDB(B0, 1, 0); PG8_LDB(B1, 1, 1); PG8_SCHED; PG8_LDA(At, 1, 0); PG8_STAGE(PG8_SA(0, 1), a2 + hstep);
            PG8_WAIT_V(8); PG8_WAIT_L(0); PG8_BAR; PG8_MMA(0, 0, At, B0); PG8_MMA(0, 1, At, B1); PG8_BAR; PG8_SCHED;
            PG8_LDA(At, 1, 1); PG8_STAGE(PG8_SB(1, 0), b3); PG8_STAGE(PG8_SB(1, 1), b3 + hstep); PG8_STAGE(PG8_SA(1, 0), a3);
            PG8_WAIT_V(8); PG8_WAIT_L(0); PG8_BAR; PG8_MMA(1, 0, At, B0); PG8_MMA(1, 1, At, B1); PG8_BAR; PG8_SCHED;
        }
        if (wr == 0) PG8_BAR;
        E(acc, cur, wr, wc, fr, fq);
        if (!has_next) break;
#pragma unroll
        for (int a = 0; a < 2; ++a)
#pragma unroll
            for (int b = 0; b < 2; ++b)
#pragma unroll
                for (int m = 0; m < 4; ++m)
#pragma unroll
                    for (int n = 0; n < 2; ++n) acc[a][b][m][n] = (f32x4){0.f, 0.f, 0.f, 0.f};
        cur = nxt; cA = nA; cB = nB; ++ui;
        if (wr == 1) PG8_BAR;
    }
    PG8_WAIT_V(0);
    PG8_BAR;
#undef PG8_SA
#undef PG8_SB
#undef PG8_STAGE
#undef PG8_LDA
#undef PG8_LDB
#undef PG8_MMA
#undef PG8_WAIT_V
#undef PG8_WAIT_L
#undef PG8_BAR
#undef PG8_SCHED
}
}

__device__ __forceinline__ float row_rstd(const float* ssp, int row) {
    const f32x4 a = *(const f32x4*)(ssp + (size_t)row * 4);
    return __builtin_amdgcn_rsqf(((a[0] + a[1]) + (a[2] + a[3])) * (1.0f / D) + EPS);
}
__device__ __forceinline__ float rstd_of(const f32x4 a) { return __builtin_amdgcn_rsqf(((a[0] + a[1]) + (a[2] + a[3])) * (1.0f / D) + EPS); }
struct EpiSwiglu {
    ECtx c;
    __device__ __forceinline__ void operator()(const f32x4 (&acc)[2][2][4][2], const pg8::Unit& u, int wr, int wc, int fr, int fq) const {
        unsigned char* ws = c.kp->ws;
        bf16_t* act = (bf16_t*)(ws + WS_ACT); const float* ssp = (const float*)(ws + WS_SSP);
        const float* bias = (const float*)(ws + WS_BIAS) + (size_t)c.l * 9 * NB + (c.k == 5 ? 7936 : 0);
        const int kind = u.pm < 32 ? 0 : 1 + ((u.pm - 32) >> 2);
        const float* bp = bias + (size_t)kind * NB + u.pn * 256 + wc * 32 + fq * 4;
        f32x4 bg[2], bu[2];
#pragma unroll
        for (int bj = 0; bj < 2; ++bj) { bg[bj] = *(const f32x4*)(bp + bj * 128); bu[bj] = *(const f32x4*)(bp + bj * 128 + 16); }
        const float* sbase = ssp + (size_t)(u.pm * 256 + wr * 64 + fr) * 4;
        f32x4 sn = *(const f32x4*)sbase;
#pragma unroll
        for (int ai = 0; ai < 2; ++ai)
#pragma unroll
            for (int m = 0; m < 4; ++m) {
                int row = u.pm * 256 + ai * 128 + wr * 64 + m * 16 + fr; asm volatile("" : "+v"(row));
                const float rs = rstd_of(sn);
                if (ai * 4 + m < 7) sn = *(const f32x4*)(sbase + (((m + 1) >> 2) + ai) * 512 + ((m + 1) & 3) * 64);
                bf16_t* rp = act + (size_t)row * FF + u.pn * 128 + wc * 32 + fq * 8;
                u32x4 w;
                { const f32x4 gg = acc[ai][0][m][0] * rs + bg[0], uu = acc[ai][0][m][1] * rs + bu[0];
                  w.x = pk2(silu_f(gg[0]) * uu[0], silu_f(gg[1]) * uu[1]); w.y = pk2(silu_f(gg[2]) * uu[2], silu_f(gg[3]) * uu[3]); }
                { const f32x4 gg = acc[ai][1][m][0] * rs + bg[1], uu = acc[ai][1][m][1] * rs + bu[1];
                  w.z = pk2(silu_f(gg[0]) * uu[0], silu_f(gg[1]) * uu[1]); w.w = pk2(silu_f(gg[2]) * uu[2], silu_f(gg[3]) * uu[3]); }
                *(u32x4*)rp = w;
            }
    }
};
struct EpiRes {
    ECtx c;
    __device__ __forceinline__ void operator()(const f32x4 (&acc)[2][2][4][2], const pg8::Unit& u, int wr, int wc, int fr, int fq) const {
        unsigned char* ws = c.kp->ws; float* xout = c.kp->out;
        const float* MOD = (const float*)(ws + WS_MOD); const float* modl = MOD + (size_t)c.l * 81 * 1024;
        const bool from_in = c.l == 0 && c.k == 1;
        const float* xin_ctx = c.kp->x_prompt; const float* xin_lat = c.kp->x_sample;
        const int gi = c.k == 4 ? 5 : (c.k == 1 ? 2 : 8); const float coef = c.k == 4 ? 1.0f : 0.5f;
        const int nsub = c.k == 4 ? 2 : (c.k == 1 ? 1 : 0), nl = c.k == 6 ? c.l + 1 : c.l;
        const float* ng = nl < 2 ? c.kp->norm_g + (size_t)(nl * 3 + nsub) * 1024 : nullptr;
        const float* nmod = MOD + (size_t)nl * 81 * 1024; const int nsc = 3 * nsub + 1;
        bf16_t* hn = (bf16_t*)(ws + WS_H); float* ssp = (float*)(ws + WS_SSP);
        LAS float* ssl = (LAS float*)c.lds_epi_;
        const int kind = u.pm < 32 ? 0 : 1 + ((u.pm - 32) >> 2);
        const float* gv = modl + (size_t)(kind * 9 + gi) * 1024;
        const int col0 = u.pn * 256 + wc * 32 + fq * 8;
        f32x4 gt[2][2], gs[2][2];
#pragma unroll
        for (int bj = 0; bj < 2; ++bj)
#pragma unroll
            for (int n = 0; n < 2; ++n) {
                gt[bj][n] = *(const f32x4*)(gv + col0 + bj * 128 + n * 4) * coef;
                if (ng) gs[bj][n] = *(const f32x4*)(ng + col0 + bj * 128 + n * 4) * (*(const f32x4*)(nmod + (size_t)(kind * 9 + nsc) * 1024 + col0 + bj * 128 + n * 4) + 1.0f);
            }
        const float* xin = u.pm < 32 ? xin_ctx : xin_lat;
        const int rbase = (u.pm < 32 ? u.pm : u.pm - 32) * 256;
        bf16_t* xb = (bf16_t*)(ws + WS_XB);
        const bool is_last = nl >= 2;
        u32x4 xnb[2];
        if (!from_in) { const bf16_t* xp0 = xb + (size_t)(u.pm * 256 + wr * 64 + fr) * D + col0;
#pragma unroll
            for (int bj = 0; bj < 2; ++bj) xnb[bj] = *(const u32x4*)(xp0 + bj * 128); }
#pragma unroll
        for (int ai = 0; ai < 2; ++ai)
#pragma unroll
            for (int m = 0; m < 4; ++m) {
                int rl = ai * 128 + wr * 64 + m * 16 + fr; asm volatile("" : "+v"(rl));
                const float* ip = xin + (size_t)(rbase + rl) * D + col0;
                float* op = xout + (size_t)(u.pm * 256 + rl) * D + col0;
                bf16_t* hp = hn + (size_t)(u.pm * 256 + rl) * D + col0;
                bf16_t* xp = xb + (size_t)(u.pm * 256 + rl) * D + col0;
                f32x4 xc[2][2];
                if (from_in) {
#pragma unroll
                    for (int bj = 0; bj < 2; ++bj)
#pragma unroll
                        for (int n = 0; n < 2; ++n) xc[bj][n] = *(const f32x4*)(ip + bj * 128 + n * 4);
                } else {
#pragma unroll
                    for (int bj = 0; bj < 2; ++bj)
#pragma unroll
                        for (int n = 0; n < 2; ++n) { const unsigned wx_ = n ? xnb[bj].z : xnb[bj].x, wy_ = n ? xnb[bj].w : xnb[bj].y;
                            xc[bj][n] = (f32x4){__builtin_bit_cast(float, wx_ << 16), __builtin_bit_cast(float, wx_ & 0xffff0000u), __builtin_bit_cast(float, wy_ << 16), __builtin_bit_cast(float, wy_ & 0xffff0000u)}; }
                    if (ai * 4 + m < 7) { const bf16_t* xpn = xp + (size_t)((m == 3 ? 128 - 48 : 16)) * D;
#pragma unroll
                        for (int bj = 0; bj < 2; ++bj) xnb[bj] = *(const u32x4*)(xpn + bj * 128); }
                }
                float ss = 0.f;
#pragma unroll
                for (int bj = 0; bj < 2; ++bj) {
                    const f32x4 x0 = xc[bj][0] + gt[bj][0] * acc[ai][bj][m][0], x1 = xc[bj][1] + gt[bj][1] * acc[ai][bj][m][1];
                    if (is_last) { *(f32x4*)(op + bj * 128) = x0; *(f32x4*)(op + bj * 128 + 4) = x1; }
                    else { u32x4 wx; wx.x = pk2(x0[0], x0[1]); wx.y = pk2(x0[2], x0[3]); wx.z = pk2(x1[0], x1[1]); wx.w = pk2(x1[2], x1[3]); *(u32x4*)(xp + bj * 128) = wx; }
                    if (ng) {
                        ss += ((x0[0] * x0[0] + x0[1] * x0[1]) + (x0[2] * x0[2] + x0[3] * x0[3])) + ((x1[0] * x1[0] + x1[1] * x1[1]) + (x1[2] * x1[2] + x1[3] * x1[3]));
                        const f32x4 h0 = x0 * gs[bj][0], h1 = x1 * gs[bj][1];
                        u32x4 wh; wh.x = pk2(h0[0], h0[1]); wh.y = pk2(h0[2], h0[3]); wh.z = pk2(h1[0], h1[1]); wh.w = pk2(h1[2], h1[3]);
                        *(u32x4*)(hp + bj * 128) = wh;
                    }
                }
                if (ng) {
                    ss += __shfl_xor(ss, 16); ss += __shfl_xor(ss, 32);
                    if (fq == 0) ssl[rl * 4 + wc] = ss;
                }
            }
        if (ng) {
            asm volatile("s_waitcnt lgkmcnt(0)" ::: "memory"); __builtin_amdgcn_s_barrier(); asm volatile("" ::: "memory");
            const int t = wr * 256 + wc * 64 + fq * 16 + fr;
            if (t < 256) { const f32x4 a = *(const LAS f32x4*)(ssl + t * 4); ssp[(size_t)(u.pm * 256 + t) * 4 + u.pn] = (a[0] + a[1]) + (a[2] + a[3]); }
        }
    }
};
struct EpiBias {
    ECtx c;
    __device__ __forceinline__ void operator()(const f32x4 (&acc)[2][2][4][2], const pg8::Unit& u, int wr, int wc, int fr, int fq) const {
        float* bias = (float*)(c.kp->ws + WS_BIAS) + (size_t)c.l * 9 * NB;
        const int which = u.pn < 22 ? 0 : (u.pn < 31 ? 1 : 2);
        if (wr != 0) return;
#pragma unroll
        for (int m = 0; m < 2; ++m) {
            const int kind = m * 16 + fr - 9 * which;
            if (kind >= 0 && kind < 9) {
#pragma unroll
                for (int bj = 0; bj < 2; ++bj)
#pragma unroll
                    for (int n = 0; n < 2; ++n) *(f32x4*)(bias + (size_t)kind * NB + u.pn * 256 + bj * 128 + wc * 32 + n * 16 + fq * 4) = acc[0][bj][m][n];
            }
        }
    }
};
struct EpiIn {
    ECtx c;
    __device__ __forceinline__ void operator()(const f32x4 (&acc)[2][2][4][2], const pg8::Unit& u, int wr, int wc, int fr, int fq) const {
        unsigned char* ws = c.kp->ws; float* out = c.kp->out; const int layer = c.l;
        const float* qg = c.kp->q_norm_g + layer * 64; const float* kg = c.kp->k_norm_g + layer * 64; const float* vng = c.kp->sg_vnorm_g + layer * 256;
        const float* ssp = (const float*)(ws + WS_SSP); const float* bias = (const float*)(ws + WS_BIAS) + (size_t)layer * 9 * NB + 5632;
        const int pn = u.pn;
        const int kind = u.pm < 32 ? 0 : 1 + ((u.pm - 32) >> 2);
        const float* sbase = ssp + (size_t)(u.pm * 256 + wr * 64 + fr) * 4;
        f32x4 sn = *(const f32x4*)sbase;
        f32x4 bz[2][2];
#pragma unroll
        for (int bj = 0; bj < 2; ++bj)
#pragma unroll
            for (int n = 0; n < 2; ++n) bz[bj][n] = *(const f32x4*)(bias + (size_t)kind * NB + pn * 256 + bj * 128 + wc * 32 + n * 16 + fq * 4);
#pragma unroll
        for (int ai = 0; ai < 2; ++ai)
#pragma unroll
            for (int m = 0; m < 4; ++m) {
                int row = u.pm * 256 + ai * 128 + wr * 64 + m * 16 + fr; asm volatile("" : "+v"(row));
                const float rs = rstd_of(sn);
                if (ai * 4 + m < 7) sn = *(const f32x4*)(sbase + (((m + 1) >> 2) + ai) * 512 + ((m + 1) & 3) * 64);
                f32x4 v[2][2];
#pragma unroll
                for (int bj = 0; bj < 2; ++bj)
#pragma unroll
                    for (int n = 0; n < 2; ++n) v[bj][n] = acc[ai][bj][m][n] * rs + bz[bj][n];
#define PK8(dst16, x0, x1) do { u32x4 w_; w_.x = pk2((x0)[0], (x0)[1]); w_.y = pk2((x0)[2], (x0)[3]); w_.z = pk2((x1)[0], (x1)[1]); w_.w = pk2((x1)[2], (x1)[3]); *(u32x4*)(dst16) = w_; } while (0)
                if (pn == 0) {
                    bf16_t* za = (bf16_t*)(ws + WS_ZA) + (size_t)row * 256 + wc * 64 + fq * 8;
#pragma unroll
                    for (int bj = 0; bj < 2; ++bj) PK8(za + bj * 32, v[bj][0], v[bj][1]);
                } else if (pn <= 4) {
                    const bool isk = pn >= 3; const int h = (isk ? pn - 3 : pn - 1) * 4 + wc;
                    bf16_t* qb = (bf16_t*)(ws + WS_Q); bf16_t* kb = (bf16_t*)(ws + WS_K);
                    float ss = 0.f;
#pragma unroll
                    for (int bj = 0; bj < 2; ++bj)
#pragma unroll
                        for (int n = 0; n < 2; ++n) ss += (v[bj][n][0] * v[bj][n][0] + v[bj][n][1] * v[bj][n][1]) + (v[bj][n][2] * v[bj][n][2] + v[bj][n][3] * v[bj][n][3]);
                    ss += __shfl_xor(ss, 16); ss += __shfl_xor(ss, 32);
                    const float rstd = __builtin_amdgcn_rsqf(ss * (1.0f / 64.0f) + EPS);
                    const float* gn = isk ? kg : qg;
                    bf16_t* dst = isk ? kb + ((size_t)h * M + (row & ~31)) * 64 + (fq >> 1) * 512 + (row & 31) * 16 + (fq & 1) * 8 : qb + ((size_t)h * M + row) * 64 + fq * 8;
#pragma unroll
                    for (int bj = 0; bj < 2; ++bj) {
                        const int dd = bj * 32 + fq * 8;
                        const float qs = isk ? rstd : rstd * (0.125f * LOG2E);
                        const f32x4 o0 = v[bj][0] * qs * *(const f32x4*)(gn + dd), o1 = v[bj][1] * qs * *(const f32x4*)(gn + dd + 4);
                        PK8(dst + (isk ? bj * 1024 : bj * 32), o0, o1);
                        if (isk && row < MCTX) { float* nk = out + NK_OFF + ((((size_t)(row >> 8) * 2 + layer) * 8 + h) * 256 + (row & 255)) * 64 + dd; *(f32x4*)nk = o0; *(f32x4*)(nk + 4) = o1; }
                    }
                } else if (pn <= 6) {
                    const int h = (pn - 5) * 4 + wc;
                    bf16_t* vt = (bf16_t*)(ws + WS_VT);
                    bf16_t* vrow = vt + ((size_t)h * M + (row & ~31)) * 64 + ((row >> 3) & 1) * 512 + ((row >> 4) & 1) * 8 + (row & 7) + fq * 128;
#pragma unroll
                    for (int bj = 0; bj < 2; ++bj)
#pragma unroll
                        for (int n = 0; n < 2; ++n) {
#pragma unroll
                            for (int j = 0; j < 4; ++j) vrow[bj * 1024 + n * 64 + j * 16] = (bf16_t)f2bf(v[bj][n][j]);
                            if (row < MCTX) *(f32x4*)(out + NV_OFF + ((((size_t)(row >> 8) * 2 + layer) * 8 + h) * 256 + (row & 255)) * 64 + bj * 32 + fq * 8 + n * 4) = v[bj][n];
                        }
                } else if (pn == 7) {
                    bf16_t* ut = (bf16_t*)(ws + WS_UT) + (size_t)row * 256 + wc * 64 + fq * 8;
#pragma unroll
                    for (int bj = 0; bj < 2; ++bj) {
                        f32x4 g0, g1;
#pragma unroll
                        for (int j = 0; j < 4; ++j) { g0[j] = gelu_tanh(v[bj][0][j]); g1[j] = gelu_tanh(v[bj][1][j]); }
                        PK8(ut + bj * 32, g0, g1);
                    }
                } else {
                    float ss = 0.f;
#pragma unroll
                    for (int bj = 0; bj < 2; ++bj)
#pragma unroll
                        for (int n = 0; n < 2; ++n) {
#pragma unroll
                            for (int j = 0; j < 4; ++j) { v[bj][n][j] = gelu_tanh(v[bj][n][j]); ss += v[bj][n][j] * v[bj][n][j]; }
                        }
                    ss += __shfl_xor(ss, 16); ss += __shfl_xor(ss, 32);
                    const float rstd = __builtin_amdgcn_rsqf(ss * (1.0f / 64.0f) + EPS);
                    bf16_t* vgt = (bf16_t*)(ws + WS_VGT);
                    bf16_t* vgrow = vgt + (size_t)(row >> 7) * 32768 + ((row >> 4) & 7) * 512 + ((row >> 3) & 1) * 8 + (row & 7) + wc * 8192 + fq * 128;
#pragma unroll
                    for (int bj = 0; bj < 2; ++bj)
#pragma unroll
                        for (int n = 0; n < 2; ++n) {
                            const f32x4 o = v[bj][n] * rstd * *(const f32x4*)(vng + wc * 64 + bj * 32 + fq * 8 + n * 4);
#pragma unroll
                            for (int j = 0; j < 4; ++j) vgrow[bj * 4096 + n * 64 + j * 16] = (bf16_t)f2bf(o[j]);
                        }
                }
#undef PK8
            }
    }
};

struct EpiAll {
    ECtx c0;
    __device__ __forceinline__ void operator()(const f32x4 (&acc)[2][2][4][2], const pg8::Unit& u, int wr, int wc, int fr, int fq) const {
        ECtx c = c0; asm volatile("" : "+s"(c.kp));
        if (u.pm < 0) { ECtx cb = c; cb.l = 1; pg8::Unit ub; ub.pm = 0; ub.pn = u.pn - 48; EpiBias{cb}(acc, ub, wr, wc, fr, fq); }
        else if (c.k == 0 || c.k == 5) EpiSwiglu{c}(acc, u, wr, wc, fr, fq); else if (c.k == 2) EpiIn{c}(acc, u, wr, wc, fr, fq); else if (c.k < 0) EpiBias{c}(acc, u, wr, wc, fr, fq); else EpiRes{c}(acc, u, wr, wc, fr, fq);
    }
};
struct Frame {
    LAS unsigned char* lds;
    int tid, lane, wave, G, bid;
};

__device__ __forceinline__ void transpose_item(const float* src  , int sstride, int K, bf16_t* WT, int n0, int k0, LAS float* scr, int lane) {
    float tv[32];
#pragma unroll
    for (int i = 0; i < 32; ++i) tv[i] = src[(size_t)(k0 + 2 * i + (lane >> 5)) * sstride];
#pragma unroll
    for (int i = 0; i < 32; ++i) scr[(2 * i + (lane >> 5)) * 33 + (lane & 31)] = tv[i];
    asm volatile("s_waitcnt lgkmcnt(0)" ::: "memory");
    const int c = lane & 7;
#pragma unroll
    for (int j = 0; j < 4; ++j) { const int n = (lane >> 3) + 8 * j; const LAS float* s = scr + (8 * c) * 33 + n;
        u32x4 o; o.x = pk2(s[0 * 33], s[1 * 33]); o.y = pk2(s[2 * 33], s[3 * 33]); o.z = pk2(s[4 * 33], s[5 * 33]); o.w = pk2(s[6 * 33], s[7 * 33]);
        *(u32x4*)(WT + (size_t)(n0 + n) * K + k0 + 8 * c) = o; }
    asm volatile("s_waitcnt lgkmcnt(0)" ::: "memory");
}

constexpr int CV_GU = 16 * 176, CV_D = 44 * 32, CV_IN = 16 * 72, CV_OUT = 16 * 32, CV_NA = 2 * CV_GU + CV_IN, CV_LAYER = CV_NA + 2 * CV_D + CV_OUT;
__device__ __forceinline__ void convert_items(const Params& p, Frame& F, int l, int lo, int hi, int widx, int nw) {
    LAS float* scr = (LAS float*)(F.lds + F.wave * 16896);
    unsigned char* wl = p.ws + WS_W + (size_t)l * W_LAYER;
    const int q = F.lane & 31;
    for (int it = lo + widx; it < hi; it += nw) {
        int r = it;
        if (r < 2 * CV_GU) {
            const int f = r / CV_GU; r %= CV_GU; const int kb = r / 176, nb = r % 176, n0 = nb * 32;
            const int tile = n0 >> 8, p0 = n0 & 255, ffcol = tile * 128 + 32 * ((p0 >> 5) & 3) + 8 * ((q & 15) >> 2) + 4 * (p0 >> 7) + (q & 3);
            const float* src = ((q >> 4) ? p.w_up : p.w_gate) + (size_t)(l * 2 + f) * D * FF + ffcol;
            transpose_item(src, FF, D, (bf16_t*)(wl + (f ? W_GU1 : W_GU0)), n0, kb * 64, scr, F.lane); continue; }
        r -= 2 * CV_GU;
        if (r < CV_IN) {
            const int kb = r / 72, nb = r % 72, n0 = nb * 32, p0 = n0 & 255;
            const int lcol = (n0 & ~255) + 64 * ((p0 >> 5) & 3) + 32 * (p0 >> 7) + 8 * ((q & 15) >> 2) + 4 * (q >> 4) + (q & 3);
            const float* src = p.w_in + (size_t)l * D * NIN + lcol;
            transpose_item(src, NIN, D, (bf16_t*)(wl + W_IN), n0, kb * 64, scr, F.lane); continue; }
        r -= CV_IN;
        if (r < 2 * CV_D) {
            const int f = r / CV_D; r %= CV_D; const int kb = r / 32, nb = r % 32, n0 = nb * 32;
            const float* src = p.w_down + (size_t)(l * 2 + f) * FF * D + n0 + (8 * ((q & 15) >> 2) + 4 * (q >> 4) + (q & 3));
            transpose_item(src, D, FF, (bf16_t*)(wl + W_D + f * W_D_SZ), n0, kb * 64, scr, F.lane); continue; }
        r -= 2 * CV_D;
        { const int kb = r / 32, nb = r % 32, n0 = nb * 32;
          const float* src = p.w_out + (size_t)l * D * D + n0 + (8 * ((q & 15) >> 2) + 4 * (q >> 4) + (q & 3));
          transpose_item(src, D, D, (bf16_t*)(wl + W_OUT), n0, kb * 64, scr, F.lane); }
    }
}

__device__ __forceinline__ void phase_prologue(const Params& p, Frame& F) {
    float* MOD = (float*)(p.ws + WS_MOD);
    for (int item = F.bid; item < 144; item += F.G) {
        const int l = item / 72, jc = item % 72;
        LAS float* sc = (LAS float*)F.lds; LAS float* red = sc + 9 * 1024;
        for (int i = F.tid; i < 9 * 1024; i += 512) { const int s = i >> 10, k = i & 1023; const float v = s == 0 ? p.c_ctx[k] : p.c[(s - 1) * 1024 + k]; sc[i] = silu_f(v); }
        __syncthreads();
        const float* w = p.ada_w + (size_t)l * 1024 * 9216 + (size_t)(F.wave * 128) * 9216 + jc * 128 + F.lane * 2;
        f32x2 acc[9];
#pragma unroll
        for (int s = 0; s < 9; ++s) acc[s] = (f32x2){0.f, 0.f};
        for (int k0 = 0; k0 < 128; k0 += 32) {
            f32x2 wv[32];
#pragma unroll
            for (int k = 0; k < 32; ++k) wv[k] = *(const f32x2*)(w + (size_t)(k0 + k) * 9216);
#pragma unroll
            for (int k = 0; k < 32; ++k) {
#pragma unroll
                for (int s = 0; s < 9; ++s) acc[s] += sc[s * 1024 + F.wave * 128 + k0 + k] * wv[k];
            }
        }
#pragma unroll
        for (int s = 0; s < 9; ++s) { red[(F.wave * 9 + s) * 128 + F.lane * 2] = acc[s].x; red[(F.wave * 9 + s) * 128 + F.lane * 2 + 1] = acc[s].y; }
        __syncthreads();
        for (int i = F.tid; i < 9 * 128; i += 512) { const int s = i >> 7, j = i & 127; float sum = p.ada_b[l * 9216 + jc * 128 + j];
#pragma unroll
            for (int w8 = 0; w8 < 8; ++w8) sum += red[(w8 * 9 + s) * 128 + j];
            MOD[(size_t)(l * 9 + s) * 9216 + jc * 128 + j] = sum;
            const int mi = jc >> 3;
            if (mi % 3 == 0) ((bf16_t*)(p.ws + WS_SHB))[((size_t)l * 256 + 9 * (mi / 3) + s) * 1024 + (jc & 7) * 128 + j] = (bf16_t)f2bf(sum); }
        __syncthreads();
    }
    const int gw = F.bid * 8 + F.wave, NGW = F.G * 8;
    LAS float* scr = (LAS float*)(F.lds + F.wave * 16896);
    { unsigned* z = (unsigned*)(p.ws + WS_SHB);
      for (int i = gw * 64 + F.lane; i < 2 * 229 * 512; i += NGW * 64) { const int l = i / (229 * 512), r = i % (229 * 512); z[((size_t)l * 256 + 27) * 512 + r] = 0u; } }
    { bf16_t* SW = (bf16_t*)(p.ws + WS_SW);
      for (int i = gw * 64 + F.lane; i < 2 * 4 * 128 * 128 / 2; i += NGW * 64) { const f32x2 v = *(const f32x2*)(p.sg_w + 2 * (size_t)i); ((unsigned*)SW)[i] = pk2(v.x, v.y); } }
    { bf16_t* PW = (bf16_t*)(p.ws + WS_PW);
      for (int i = gw * 64 + F.lane; i < 2 * 4 * 64 * 64; i += NGW * 64) { const int c = i & 63, d = (i >> 6) & 63, lg = i >> 12; PW[i] = (bf16_t)f2bf(p.pool_w[((size_t)lg * 64 + c) * 64 + d]); } }
    { bf16_t* CK = (bf16_t*)(p.ws + WS_CK); bf16_t* CVT = (bf16_t*)(p.ws + WS_CVT);
      for (int it = gw; it < 128 * 4; it += NGW) {
          const int mat = it >> 2, t0 = (it & 3) * 64;
          const float* ks = p.cache_k + ((size_t)mat * 256 + t0) * 64; const float* vs = p.cache_v + ((size_t)mat * 256 + t0) * 64;
          const int d = F.lane;
#pragma unroll 8
          for (int t = 0; t < 64; ++t) {
              const int tt = t0 + t, key = tt & 31; const size_t tb = ((size_t)mat * 8 + (tt >> 5)) * 2048;
              CK[tb + ((d >> 4) * 32 + key) * 16 + (d & 15)] = (bf16_t)f2bf(ks[t * 64 + d]);
              CVT[tb + (((d >> 5) * 2 + ((key >> 3) & 1)) * 32 + (d & 31)) * 16 + (key >> 4) * 8 + (key & 7)] = (bf16_t)f2bf(vs[t * 64 + d]);
          }
      } }
    convert_items(p, F, 0, 0, CV_NA, gw, NGW);
    if (F.G != 256) { convert_items(p, F, 0, CV_NA, CV_LAYER, gw, NGW); convert_items(p, F, 1, 0, CV_LAYER, gw, NGW); }
}

__device__ __forceinline__ void phase_norm0(const Params& p, Frame& F) {
    bf16_t* H = (bf16_t*)(p.ws + WS_H); float* SSP = (float*)(p.ws + WS_SSP);
    const float* modl = (const float*)(p.ws + WS_MOD);
    const bool split = F.G == 256;
    if (split && F.bid < 53) return;
    const int gw = (split ? F.bid - 53 : F.bid) * 8 + F.wave, NGW = (split ? F.G - 53 : F.G) * 8;
    for (int r0 = gw * 8; r0 < M; r0 += NGW * 8) {
        const int kind = kind_of_row(r0);
        const float* sc = modl + (size_t)(kind * 9 + 1) * 1024;
        f32x4 gs[4];
#pragma unroll
        for (int j = 0; j < 4; ++j) { const int col = 4 * F.lane + 256 * j; gs[j] = *(const f32x4*)(p.norm_g + col) * (*(const f32x4*)(sc + col) + 1.0f); }
#pragma unroll 4
        for (int rr = 0; rr < 8; ++rr) {
            const int row = r0 + rr;
            const float* xr = row < MCTX ? p.x_prompt + (size_t)row * D : p.x_sample + (size_t)(row - MCTX) * D;
            f32x4 v[4]; float s = 0.f;
#pragma unroll
            for (int j = 0; j < 4; ++j) { v[j] = *(const f32x4*)(xr + 4 * F.lane + 256 * j); s += (v[j][0] * v[j][0] + v[j][1] * v[j][1]) + (v[j][2] * v[j][2] + v[j][3] * v[j][3]); }
            s = wave_sum(s);
            if (F.lane < 4) SSP[(size_t)row * 4 + F.lane] = F.lane == 0 ? s : 0.f;
#pragma unroll
            for (int j = 0; j < 4; ++j) { const f32x4 o = v[j] * gs[j]; u32x2 w; w.x = pk2(o[0], o[1]); w.y = pk2(o[2], o[3]);
                *(u32x2*)(H + (size_t)row * D + 4 * F.lane + 256 * j) = w; }
        }
    }
}

__device__ __forceinline__ float half_max(float v) {
    const auto rr = __builtin_amdgcn_permlane32_swap(__builtin_bit_cast(unsigned, v), __builtin_bit_cast(unsigned, v), false, false);
    return fmaxf(__builtin_bit_cast(float, (unsigned)rr[0]), __builtin_bit_cast(float, (unsigned)rr[1]));
}
__device__ __forceinline__ float half_sum(float v) {
    const auto rr = __builtin_amdgcn_permlane32_swap(__builtin_bit_cast(unsigned, v), __builtin_bit_cast(unsigned, v), false, false);
    return __builtin_bit_cast(float, (unsigned)rr[0]) + __builtin_bit_cast(float, (unsigned)rr[1]);
}
struct AttnState { f32x16 O0, O1; float m, l; };
struct KF { bf16x8 k[4]; };
struct VF { bf16x8 v[2][2]; };
__device__ __forceinline__ void load_k(KF& f, const bf16_t* Kp, int lane) {
    const int rho = lane & 31, key = 16 * ((rho >> 2) & 1) + 4 * (rho >> 3) + (rho & 3);
    const bf16_t* kp = Kp + key * 16 + (lane >> 5) * 8;
#pragma unroll
    for (int c = 0; c < 4; ++c) f.k[c] = *(const bf16x8*)(kp + 512 * c);
}
__device__ __forceinline__ void load_v(VF& f, const bf16_t* Vp, int lane) {
    const bf16_t* vp = Vp + (lane & 31) * 16 + (lane >> 5) * 8;
#pragma unroll
    for (int mb = 0; mb < 2; ++mb)
#pragma unroll
        for (int c = 0; c < 2; ++c) f.v[mb][c] = *(const bf16x8*)(vp + (mb * 2 + c) * 512);
}
template <bool LOCAL>
__device__ __forceinline__ f32x16 qk_part(const bf16x8 (&qf)[4], const KF& f, int lane, const LAS float* bl, int th, int qc, int cs) {
    const int g = lane >> 5;
    f32x16 S;
#pragma unroll
    for (int i = 0; i < 16; ++i) S[i] = 0.f;
#pragma unroll
    for (int c = 0; c < 4; ++c) S = __builtin_amdgcn_mfma_f32_32x32x16_bf16(f.k[c], qf[c], S, 0, 0, 0);
    if (LOCAL) {
        const LAS float* bp = bl + (63 + th * 32 + 16 * g - qc);
        const int rel0 = th * 32 + 16 * g - cs;
        float bv[16];
#pragma unroll
        for (int i = 0; i < 16; ++i) bv[i] = bp[i];
#pragma unroll
        for (int i = 0; i < 16; ++i) {
            const float pen = (unsigned)(rel0 + i) < 16u ? 0.f : -1e30f;
            S[i] = (S[i] + bv[i]) + pen;
        }
    }
    return S;
}
__device__ __forceinline__ void pv_part(AttnState& st, f32x16 S, const VF& f) {
    float mt = S[0];
#pragma unroll
    for (int i = 1; i < 16; ++i) mt = fmaxf(mt, S[i]);
    mt = half_max(mt);
    if (__any(mt - st.m > 8.0f)) {
        const float mn = fmaxf(st.m, mt);
        const float alpha = __builtin_amdgcn_exp2f(st.m - mn);
        st.m = mn; st.l *= alpha;
#pragma unroll
        for (int i = 0; i < 16; ++i) { st.O0[i] *= alpha; st.O1[i] *= alpha; }
    }
    float ps = 0.f;
#pragma unroll
    for (int i = 0; i < 16; ++i) { S[i] = __builtin_amdgcn_exp2f(S[i] - st.m); ps += S[i]; }
    st.l += ps;
    bf16x8 pf[2];
#pragma unroll
    for (int c = 0; c < 2; ++c) {
        u32x4 w; w.x = pk2(S[8 * c + 0], S[8 * c + 1]); w.y = pk2(S[8 * c + 2], S[8 * c + 3]); w.z = pk2(S[8 * c + 4], S[8 * c + 5]); w.w = pk2(S[8 * c + 6], S[8 * c + 7]);
        pf[c] = __builtin_bit_cast(bf16x8, w);
    }
#define VFR(mb, c) (f.v[mb][c])
    st.O0 = __builtin_amdgcn_mfma_f32_32x32x16_bf16(VFR(0, 0), pf[0], st.O0, 0, 0, 0);
    st.O0 = __builtin_amdgcn_mfma_f32_32x32x16_bf16(VFR(0, 1), pf[1], st.O0, 0, 0, 0);
    st.O1 = __builtin_amdgcn_mfma_f32_32x32x16_bf16(VFR(1, 0), pf[0], st.O1, 0, 0, 0);
    st.O1 = __builtin_amdgcn_mfma_f32_32x32x16_bf16(VFR(1, 1), pf[1], st.O1, 0, 0, 0);
#undef VFR
}
template <bool LOCAL>
__device__ __forceinline__ void attn_run(AttnState& st, const bf16x8 (&qf)[4], const bf16_t* K0, const bf16_t* V0, int ntiles, int lane,
                                         const LAS float* rpbL, int r, int start, int qc, int cs) {
    KF ka, kb; VF va, vb;
    load_k(ka, K0, lane); load_v(va, V0, lane);
    for (int t = 0; t < ntiles; t += 2) {
        const LAS float* bl = rpbL + (start + (t >> 1) - r + 7) * 128;
        load_k(kb, K0 + (size_t)(t + 1) * 2048, lane);
        f32x16 S = qk_part<LOCAL>(qf, ka, lane, bl, 0, qc, cs);
        load_v(vb, V0 + (size_t)(t + 1) * 2048, lane);
        pv_part(st, S, va);
        const int tn = t + 2 < ntiles ? t + 2 : 0;
        load_k(ka, K0 + (size_t)tn * 2048, lane);
        S = qk_part<LOCAL>(qf, kb, lane, bl, 1, qc, cs);
        load_v(va, V0 + (size_t)tn * 2048, lane);
        pv_part(st, S, vb);
    }
}
__device__ __forceinline__ void attn_finish(Frame& F, AttnState& st, int q0, int h, const float* gb  , bf16_t* OB) {
    const int g = F.lane >> 5, ql = F.lane & 31;
    const float lt = half_sum(st.l);
    const float inv = 1.0f / lt;
    float ss = 0.f;
#pragma unroll
    for (int i = 0; i < 16; ++i) { st.O0[i] *= inv; st.O1[i] *= inv; ss += st.O0[i] * st.O0[i] + st.O1[i] * st.O1[i]; }
    ss = half_sum(ss);
    LAS float* hs = (LAS float*)(F.lds + 61440);
    if (g == 0) hs[h * 32 + ql] = ss;
    __syncthreads();
    float tot = 0.f;
#pragma unroll
    for (int hh = 0; hh < 8; ++hh) tot += hs[hh * 32 + ql];
    const float rstd = __builtin_amdgcn_rsqf(tot * (1.0f / 512.0f) + EPS);
    bf16_t* orow = OB + (size_t)(q0 + ql) * D + 256 + h * 64;
#pragma unroll
    for (int mb = 0; mb < 2; ++mb)
#pragma unroll
        for (int i = 0; i < 4; ++i) {
            const int d = 32 * mb + 8 * i + 4 * g;
            const f32x4 gv = *(const f32x4*)(gb + h * 64 + d);
            float o[4];
#pragma unroll
            for (int j = 0; j < 4; ++j) o[j] = (mb == 0 ? st.O0[4 * i + j] : st.O1[4 * i + j]) * rstd * gv[j];
            u32x2 w; w.x = pk2(o[0], o[1]); w.y = pk2(o[2], o[3]);
            *(u32x2*)(orow + d) = w;
        }
    __syncthreads();
}

__device__ __forceinline__ void pool_unit(const Params& p, Frame& F, int l, int u, const bf16_t* ZA, const bf16_t* PWT, bf16_t* OB, const float* ong) {
    const int lane = F.lane, g2 = lane >> 5, ql = lane & 31, w = F.wave;
    const int row0 = u * 32;
    const int seq0 = row0 < MCTX ? (row0 & ~255) : MCTX + ((row0 - MCTX) & ~1023);
    const int L = row0 < MCTX ? 256 : 1024, tloc = row0 - seq0;
    LAS float* A = (LAS float*)F.lds;
    LAS float* P = A + 48 * 256;
    LAS float* part = P + 32 * 260;
    bf16x8 af[4];
    { const bf16_t* ap = PWT + ((size_t)(l * 4 + (w >> 1)) * 64 + 32 * (w & 1) + ql) * 64 + 8 * g2;
#pragma unroll
      for (int kc = 0; kc < 4; ++kc) af[kc] = *(const bf16x8*)(ap + 16 * kc); }
    {
        unsigned wd[12];
#pragma unroll
        for (int it = 0; it < 12; ++it) { const int i = F.tid + it * 512, rr = i >> 7, cp = i & 127, tl = tloc - 8 + rr;
            wd[it] = 0u; if (tl >= 0 && tl < L) wd[it] = *(const unsigned*)(ZA + (size_t)(seq0 + tl) * 256 + 2 * cp); }
#pragma unroll
        for (int it = 0; it < 12; ++it) { const int i = F.tid + it * 512, rr = i >> 7, cp = i & 127;
            A[rr * 256 + 2 * cp] = __builtin_bit_cast(float, wd[it] << 16); A[rr * 256 + 2 * cp + 1] = __builtin_bit_cast(float, wd[it] & 0xffff0000u); }
    }
    __syncthreads();
    {
        const int ch = F.tid & 255, thh = F.tid >> 8, gi = ch >> 6;
        float a[31];
#pragma unroll
        for (int i = 0; i < 31; ++i) a[i] = A[(16 * thh + i) * 256 + ch];
#define POOL_WIN(HALF) do { _Pragma("unroll") for (int t = 0; t < 16; ++t) { float sm = 0.f; _Pragma("unroll") for (int j = -HALF; j < HALF; ++j) sm += a[8 + t + j]; \
            const int tl = tloc + 16 * thh + t; const int lo = max(tl - HALF, 0), hi = min(tl + HALF, L); \
            P[(16 * thh + t) * 260 + ch] = sm * __builtin_amdgcn_rcpf((float)(hi - lo)) - a[8 + t]; } } while (0)
        if (gi == 0) POOL_WIN(1); else if (gi == 1) POOL_WIN(2); else if (gi == 2) POOL_WIN(4); else POOL_WIN(8);
#undef POOL_WIN
    }
    __syncthreads();
    f32x16 Dm;
#pragma unroll
    for (int i = 0; i < 16; ++i) Dm[i] = 0.f;
    { const LAS float* pp = P + ql * 260 + (w >> 1) * 64 + 8 * g2;
#pragma unroll
      for (int kc = 0; kc < 4; ++kc) {
          const f32x4 x0 = *(const LAS f32x4*)(pp + 16 * kc), x1 = *(const LAS f32x4*)(pp + 16 * kc + 4);
          u32x4 wd; wd.x = pk2(x0[0], x0[1]); wd.y = pk2(x0[2], x0[3]); wd.z = pk2(x1[0], x1[1]); wd.w = pk2(x1[2], x1[3]);
          Dm = __builtin_amdgcn_mfma_f32_32x32x16_bf16(af[kc], __builtin_bit_cast(bf16x8, wd), Dm, 0, 0, 0);
      } }
    float ss = 0.f;
#pragma unroll
    for (int i = 0; i < 4; ++i) { const f32x4 ps = *(const f32x4*)(p.pool_scale + l * 256 + 32 * w + 8 * i + 4 * g2);
#pragma unroll
        for (int j = 0; j < 4; ++j) { Dm[4 * i + j] *= ps[j]; ss += Dm[4 * i + j] * Dm[4 * i + j]; } }
    ss = half_sum(ss);
    if (g2 == 0) part[w * 32 + ql] = ss;
    __syncthreads();
    float tot = 0.f;
#pragma unroll
    for (int w8 = 0; w8 < 8; ++w8) tot += part[w8 * 32 + ql];
    const float rstd = __builtin_amdgcn_rsqf(tot * (1.0f / 256.0f) + EPS);
#pragma unroll
    for (int i = 0; i < 4; ++i) { const int oc = 32 * w + 8 * i + 4 * g2; const f32x4 gv = *(const f32x4*)(ong + oc);
        u32x2 wv; wv.x = pk2(Dm[4 * i] * rstd * gv[0], Dm[4 * i + 1] * rstd * gv[1]); wv.y = pk2(Dm[4 * i + 2] * rstd * gv[2], Dm[4 * i + 3] * rstd * gv[3]);
        *(u32x2*)(OB + (size_t)(row0 + ql) * D + oc) = wv; }
    __syncthreads();
}

__device__ __forceinline__ void chunk_unit(const Params& p, Frame& F, int l, int u, const bf16_t* UB, const bf16_t* VGT, const bf16_t* SW, bf16_t* OB, const float* ong) {
    const int lane = F.lane, g = lane >> 5, ql = lane & 31;
    const int row0 = u * 128, w = F.wave, tb = w & 3, chh = w >> 2;
    const int tok = row0 + 32 * tb + ql;
    LAS float* part = (LAS float*)F.lds;
    float outv[2][2][16]; float ss = 0.f;
#pragma unroll
    for (int gs = 0; gs < 2; ++gs) {
        const int gi = 2 * chh + gs;
        bf16x8 bw[8];
        const bf16_t* wp = SW + ((size_t)(l * 4 + gi) * 128 + 32 * tb + ql) * 128 + 8 * g;
#pragma unroll
        for (int kc = 0; kc < 8; ++kc) bw[kc] = *(const bf16x8*)(wp + 16 * kc);
        const float bsv = p.sg_b[(size_t)(l * 4 + gi) * 128 + 32 * tb + ql];
#pragma unroll
        for (int cb = 0; cb < 2; ++cb) {
            const int ch0 = 64 * gi + 32 * cb;
            const bf16_t* ap = VGT + ((size_t)(u * 8 + 2 * gi + cb) * 8) * 512 + ql * 16 + 8 * g;
            s16x4 uv[4];
#pragma unroll
            for (int i = 0; i < 4; ++i) uv[i] = *(const s16x4*)(UB + (size_t)tok * 256 + ch0 + 8 * i + 4 * g);
            f32x16 Dm;
#pragma unroll
            for (int i = 0; i < 16; ++i) Dm[i] = 0.f;
#pragma unroll
            for (int kc = 0; kc < 8; ++kc) { const bf16x8 af = *(const bf16x8*)(ap + 512 * kc); Dm = __builtin_amdgcn_mfma_f32_32x32x16_bf16(af, bw[kc], Dm, 0, 0, 0); }
#pragma unroll
            for (int i = 0; i < 4; ++i)
#pragma unroll
                for (int j = 0; j < 4; ++j) { const float o = bf2f((unsigned short)uv[i][j]) * (Dm[4 * i + j] + bsv); outv[gs][cb][4 * i + j] = o; ss += o * o; }
        }
    }
    ss = half_sum(ss);
    if (g == 0) part[chh * 128 + 32 * tb + ql] = ss;
    __syncthreads();
    const float tot = part[32 * tb + ql] + part[128 + 32 * tb + ql];
    const float rstd = __builtin_amdgcn_rsqf(tot * (1.0f / 256.0f) + EPS);
#pragma unroll
    for (int gs = 0; gs < 2; ++gs)
#pragma unroll
        for (int cb = 0; cb < 2; ++cb)
#pragma unroll
            for (int i = 0; i < 4; ++i) {
                const int ch = 64 * (2 * chh + gs) + 32 * cb + 8 * i + 4 * g;
                const f32x4 gv = *(const f32x4*)(ong + 768 + ch);
                u32x2 wv; wv.x = pk2(outv[gs][cb][4 * i] * rstd * gv[0], outv[gs][cb][4 * i + 1] * rstd * gv[1]); wv.y = pk2(outv[gs][cb][4 * i + 2] * rstd * gv[2], outv[gs][cb][4 * i + 3] * rstd * gv[3]);
                *(u32x2*)(OB + (size_t)tok * D + 768 + ch) = wv;
            }
    __syncthreads();
}

__device__ __forceinline__ void phase_mix(const Params& p, Frame& F, int l) {
    const int lane = F.lane, h = F.wave, g = lane >> 5, ql = lane & 31;
    const int vb = (F.G % 8 == 0) ? (F.bid % 8) * (F.G / 8) + F.bid / 8 : F.bid;
    {
    const bf16_t* QB = (const bf16_t*)(p.ws + WS_Q); const bf16_t* KB = (const bf16_t*)(p.ws + WS_K); const bf16_t* VT = (const bf16_t*)(p.ws + WS_VT);
    const bf16_t* CK = (const bf16_t*)(p.ws + WS_CK); const bf16_t* CVT = (const bf16_t*)(p.ws + WS_CVT);
    bf16_t* OB = (bf16_t*)(p.ws + WS_OB);
    const float* ong = p.out_norm_g + l * 1024;
    for (int u = vb; u < 256; u += F.G) {
        const int b = u >> 5, r = (u >> 1) & 15, qh = u & 1;
        const int q0 = MCTX + b * 1024 + r * 64 + qh * 32;
        LAS float* rpbL = (LAS float*)(F.lds + F.wave * 7680);
        for (int i = lane; i < 15 * 128; i += 64) rpbL[i] = 0.f;
        { float tv[8];
#pragma unroll
          for (int k = 0; k < 8; ++k) { const int i = lane + 64 * k; tv[k] = i < 465 ? p.na_rpb[((size_t)l * 8 + h) * 465 + i] : 0.f; }
#pragma unroll
          for (int k = 0; k < 8; ++k) { const int i = lane + 64 * k; if (i < 465) rpbL[(i / 31) * 128 + 48 + (i % 31)] = tv[k] * LOG2E; } }
        bf16x8 qf[4];
#pragma unroll
        for (int c = 0; c < 4; ++c) qf[c] = *(const bf16x8*)(QB + ((size_t)h * M + q0 + ql) * 64 + 16 * c + 8 * g);
        AttnState st;
#pragma unroll
        for (int i = 0; i < 16; ++i) { st.O0[i] = 0.f; st.O1[i] = 0.f; }
        st.m = -1e30f; st.l = 0.f;
        const bf16_t* ck = CK + (size_t)((b * 2 + l) * 8 + h) * 256 * 64; const bf16_t* cvt = CVT + (size_t)((b * 2 + l) * 8 + h) * 64 * 256;
        attn_run<false>(st, qf, ck, cvt, 8, lane, rpbL, 0, 0, 0, 0);
        const int start = min(max(r - 4, 0), 8);
        const int qc = qh * 32 + ql, cs = min(max(qc - 8, 0), 48);
        const size_t toff = ((size_t)h * M + MCTX + b * 1024 + start * 64) * 64;
        attn_run<true>(st, qf, KB + toff, VT + toff, 16, lane, rpbL, r, start, qc, cs);
        attn_finish(F, st, q0, h, ong + 256, OB);
    }
    for (int u = vb; u < 256; u += F.G) {
        const int b = u >> 3, qb = u & 7, q0 = b * 256 + qb * 32;
        bf16x8 qf[4];
#pragma unroll
        for (int c = 0; c < 4; ++c) qf[c] = *(const bf16x8*)(QB + ((size_t)h * M + q0 + ql) * 64 + 16 * c + 8 * g);
        AttnState st;
#pragma unroll
        for (int i = 0; i < 16; ++i) { st.O0[i] = 0.f; st.O1[i] = 0.f; }
        st.m = -1e30f; st.l = 0.f;
        const size_t toff = ((size_t)h * M + b * 256) * 64;
        attn_run<false>(st, qf, KB + toff, VT + toff, 8, lane, (const LAS float*)F.lds, 0, 0, 0, 0);
        attn_finish(F, st, q0, h, ong + 256, OB);
    }
    }
    const bf16_t* ZA = (const bf16_t*)(p.ws + WS_ZA); const bf16_t* UB = (const bf16_t*)(p.ws + WS_UT); const bf16_t* VGT = (const bf16_t*)(p.ws + WS_VGT);
    const bf16_t* SW = (const bf16_t*)(p.ws + WS_SW); const bf16_t* PWT = (const bf16_t*)(p.ws + WS_PW);
    bf16_t* OB = (bf16_t*)(p.ws + WS_OB);
    const float* ong = p.out_norm_g + l * 1024;
    if (F.G == 256) {
        if (F.bid < 128) { chunk_unit(p, F, l, F.bid, UB, VGT, SW, OB, ong); pool_unit(p, F, l, F.bid, ZA, PWT, OB, ong); }
        else { for (int i = 0; i < 3; ++i) pool_unit(p, F, l, 128 + (F.bid - 128) * 3 + i, ZA, PWT, OB, ong); }
    } else {
        for (int u = F.bid; u < 128; u += F.G) chunk_unit(p, F, l, u, UB, VGT, SW, OB, ong);
        for (int u = F.bid; u < 512; u += F.G) pool_unit(p, F, l, u, ZA, PWT, OB, ong);
    }
}

#define XB_TMO      128
#define XB_XCNT(j)  (256  + 64 * (j))
#define XB_XSUB(j)  (1280 + 64 * (j))
#define XB_XGEN(j)  (2304 + 64 * (j))
#define XB_TOP      3328
#define XB_TOPGEN   3392
#define XCD_BAR_WORDS 3456
#define XB_SPIN_CAP (1u << 18)
__device__ __forceinline__ unsigned xb_ld(unsigned* p)              { return __hip_atomic_load(p, __ATOMIC_RELAXED, __HIP_MEMORY_SCOPE_AGENT); }
__device__ __forceinline__ unsigned xb_add(unsigned* p, unsigned v) { return __hip_atomic_fetch_add(p, v, __ATOMIC_RELAXED, __HIP_MEMORY_SCOPE_AGENT); }
__device__ __forceinline__ unsigned xb_xcc_id() { return (unsigned)__builtin_amdgcn_s_getreg((3 << 11) | 20) & 0xFu; }
#define XB_SPIN(cond, bar) do { unsigned _sp = 0; while (cond) { __builtin_amdgcn_s_sleep(1); \
    if ((++_sp & 255u) == 0u) { if (xb_ld(&(bar)[XB_TMO])) break; if (_sp > XB_SPIN_CAP) { atomicAdd(&(bar)[XB_TMO], 1u); break; } } } } while (0)
struct XcdBarrier { unsigned* bar; unsigned x; volatile LAS unsigned* st; };
__device__ __forceinline__ XcdBarrier xcd_barrier_post(unsigned* bar, volatile LAS unsigned* st) {
    XcdBarrier b; b.bar = bar; b.x = xb_xcc_id(); b.st = st;
    if (threadIdx.x == 0) (void)xb_add(&bar[XB_XCNT(b.x)], 1u);
    return b;
}
__device__ __forceinline__ void xcd_barrier_complete(unsigned* bar, unsigned x, unsigned& nloc, unsigned& nx) {
    const unsigned G = gridDim.x * gridDim.y * gridDim.z;
    unsigned sum, cnt, mine, sp = 0u;
    for (;;) {
        sum = 0u; cnt = 0u; mine = 0u;
#pragma unroll
        for (unsigned j = 0; j < 16; ++j) { const unsigned c = xb_ld(&bar[XB_XCNT(j)]); sum += c; cnt += (c > 0u) ? 1u : 0u; mine = (j == x) ? c : mine; }
        if (sum == G) break;
        __builtin_amdgcn_s_sleep(1);
        if ((++sp & 255u) == 0u) { if (xb_ld(&bar[XB_TMO])) break; if (sp > XB_SPIN_CAP) { atomicAdd(&bar[XB_TMO], 1u); break; } }
    }
    nloc = mine > 0u ? mine : 1u; nx = cnt > 0u ? cnt : 1u;
}
__device__ __forceinline__ void xcd_barrier(const XcdBarrier& b) {
    asm volatile("s_waitcnt vmcnt(0)" ::: "memory");
    __syncthreads();
    if (threadIdx.x == 0) {
        unsigned* bar = b.bar;
        __builtin_amdgcn_s_waitcnt(0);
        unsigned nloc = b.st[0], nx = b.st[1];
        if (nloc == 0u) { xcd_barrier_complete(bar, b.x, nloc, nx); b.st[0] = nloc; b.st[1] = nx; }
        const unsigned old = xb_add(&bar[XB_XSUB(b.x)], 1u);
        const unsigned gen = old / nloc;
        if (old + 1u == (gen + 1u) * nloc) {
            __builtin_amdgcn_fence(__ATOMIC_RELEASE, "agent");
            asm volatile("s_waitcnt vmcnt(0)" ::: "memory");
            const unsigned og = xb_add(&bar[XB_TOP], 1u);
            const unsigned tg = og / nx;
            if (og + 1u == (tg + 1u) * nx) xb_add(&bar[XB_TOPGEN], 1u);
            else XB_SPIN(xb_ld(&bar[XB_TOPGEN]) == tg, bar);
            __builtin_amdgcn_fence(__ATOMIC_ACQUIRE, "agent");
            xb_add(&bar[XB_XGEN(b.x)], 1u);
            asm volatile("s_waitcnt vmcnt(0)" ::: "memory");
        } else {
            XB_SPIN(xb_ld(&bar[XB_XGEN(b.x)]) == gen, bar);
            __builtin_amdgcn_fence(__ATOMIC_ACQUIRE, "agent");
            asm volatile("s_waitcnt vmcnt(0)" ::: "memory");
        }
    }
    __syncthreads();
}

constexpr int LDS_MISC = 135168;
constexpr int LDS_BYTES = LDS_MISC + 64;
constexpr int NPHASE = 16;

__global__ void __launch_bounds__(512, 2) fwd_megakernel(Params p_in) {
    extern __shared__ __attribute__((aligned(16))) unsigned char lds_raw[];
    cg::grid_group grid = cg::this_grid();
    { volatile LAS unsigned* st0 = (volatile LAS unsigned*)((LAS unsigned char*)lds_raw + LDS_MISC); if (threadIdx.x < 16) st0[threadIdx.x] = 0u; }
    __syncthreads();
    (void)xcd_barrier_post((unsigned*)(p_in.ws + WS_CTL), (volatile LAS unsigned*)((LAS unsigned char*)lds_raw + LDS_MISC));
#define XBAR() do { XcdBarrier xb_; xb_.bar = (unsigned*)(p_in.ws + WS_CTL); xb_.x = xb_xcc_id(); xb_.st = (volatile LAS unsigned*)((LAS unsigned char*)lds_raw + LDS_MISC); xcd_barrier(xb_); } while (0)
    if (p_in.ph_lo < 0) grid.sync();
    int rep_ = 0;
    int wave_s = __builtin_amdgcn_readfirstlane((int)threadIdx.x >> 6);
    KargPtr kp4 = (KargPtr)__builtin_amdgcn_kernarg_segment_ptr();
    const int ph_hi_ = p_in.ph_hi;
#pragma nounroll
    for (int ph = p_in.ph_lo; ph < ph_hi_; ++ph) {
        asm volatile("" : "+s"(wave_s));
        int lane_ = (int)__builtin_amdgcn_mbcnt_hi(~0u, __builtin_amdgcn_mbcnt_lo(~0u, 0u)); asm volatile("" : "+v"(lane_));
        int tid_ = wave_s * 64 + lane_;
        asm volatile("" : "+s"(kp4));
#if defined(__HIP_DEVICE_COMPILE__)
        const Params p = *kp4;
#else
        const Params p = p_in;
#endif
        int bid_ = blockIdx.x; asm volatile("" : "+s"(bid_));
        unsigned lds0 = 0; asm volatile("" : "+s"(lds0));
        Frame F;
        F.lds = (LAS unsigned char*)lds_raw + lds0;
        F.tid = tid_; F.lane = F.tid & 63; F.wave = __builtin_amdgcn_readfirstlane(F.tid >> 6);
        F.G = gridDim.x; F.bid = bid_;
        const float* MOD = (const float*)(p.ws + WS_MOD);
        bf16_t* H = (bf16_t*)(p.ws + WS_H); bf16_t* ACT = (bf16_t*)(p.ws + WS_ACT); bf16_t* OB = (bf16_t*)(p.ws + WS_OB);
        float* X = p.out;
        if (ph == 0) {
#if !defined(MASK) || ((MASK>>0)&1)
            phase_prologue(p, F);
#endif
        } else {
            const int l = ph == 1 ? 0 : (ph - 2) / 7, k = ph == 1 ? -1 : (ph - 2) % 7;
            const float* modl = MOD + (size_t)l * 81 * 1024;
            unsigned char* wl = p.ws + WS_W + (size_t)l * W_LAYER;
            if (k == 3) {
#if !defined(MASK) || ((MASK>>5)&1)
                phase_mix(p, F, l);
#endif
            } else {
#if !defined(MASK) || ((MASK>>2)&1)
                EpiAll E; E.c0 = ECtx{kp4, l, k, F.lds + 131072};
                pg8::Gemm g; int N;
                if (k == -1) { g = pg8::Gemm{(const bf16_t*)(p.ws + WS_SHB), (const bf16_t*)(p.ws + WS_W), 256, NB, D}; N = NB; }
                else if (k == 0 || k == 5) { g = pg8::Gemm{H, (const bf16_t*)(wl + (k == 0 ? W_GU0 : W_GU1)), M, NGU, D}; N = NGU; }
                else if (k == 4) { g = pg8::Gemm{OB, (const bf16_t*)(wl + W_OUT), M, D, D}; N = D; }
                else if (k == 2) { g = pg8::Gemm{H, (const bf16_t*)(wl + W_IN), M, NIN, D}; N = NIN; }
                else { const int f = k == 1 ? 0 : 1; g = pg8::Gemm{ACT, (const bf16_t*)(wl + W_D + f * W_D_SZ), M, D, FF}; N = D; }
                pg8::StaticOrder S;
                const bool full = F.G == 256;
                if (k == -1) {
                    const int lb = F.bid < 53 ? 0 : 1;
                    g.A = (const bf16_t*)(p.ws + WS_SHB) + (size_t)lb * 256 * 1024; g.Bt = (const bf16_t*)(p.ws + WS_W + (size_t)lb * W_LAYER); E.c0.l = lb;
                    S.init(256, NB, 53, F.bid % 53);
                    if (F.bid >= (full ? 53 : 106)) S.nwg = 0;
                } else {
                    S.init(M, N, F.G, F.bid);
                    if (full && l == 0 && k == 5 && F.bid >= 203) { S.exi = 5; S.expm = -167; S.expn = 48 + (F.bid - 203); }
                }
                pg8::gemm_phase<EpiAll>(F.lds, F.tid, g, S, E);
                if (k == -1) phase_norm0(p, F);
                if (full && l == 0) {
                    if (k == 0 && F.bid >= 128) convert_items(p, F, 0, CV_NA, CV_LAYER, (F.bid - 128) * 8 + F.wave, 128 * 8);
                    if (k == 2 && F.bid >= 64) convert_items(p, F, 1, 0, CV_NA, (F.bid - 64) * 8 + F.wave, 192 * 8);
                    if (k == 5 && F.bid >= 128 && F.bid < 203) convert_items(p, F, 1, CV_NA, CV_LAYER, (F.bid - 128) * 8 + F.wave, 75 * 8);
                }
#endif
            }
        }
#if PROBE_REP
        { const int kind_ = ph < 2 ? ph : 2 + (ph - 2) % 7;
          if (((PROBE_REP >> kind_) & 1) && rep_ == 0) { rep_ = 1; XBAR(); --ph; continue; }
          rep_ = 0; }
#endif
        if (ph + 1 < ph_hi_) XBAR();
    }
    for (int i_ = 0; i_ < PROBE_SYNC; ++i_) XBAR();
}

extern "C" void kernel_launch(void* const* d_in, const int* in_sizes, int n_in, void* d_out, int out_size, void* d_ws, size_t ws_size, hipStream_t stream) {
    static int grid_blocks = 0;
    if (!grid_blocks) {
        int dev = 0, cus = 0, per_cu = 0;
        hipGetDevice(&dev);
        hipDeviceGetAttribute(&cus, hipDeviceAttributeMultiprocessorCount, dev);
        hipFuncSetAttribute((const void*)fwd_megakernel, hipFuncAttributeMaxDynamicSharedMemorySize, LDS_BYTES);
        hipOccupancyMaxActiveBlocksPerMultiprocessor(&per_cu, (const void*)fwd_megakernel, 512, LDS_BYTES);
        if (per_cu < 1) { fprintf(stderr, "kernel_launch: occupancy query reports %d blocks per CU\n", per_cu); per_cu = 1; }
        grid_blocks = cus;
        (void)hipGetLastError();
    }
    Params p{};
    const float** pp = (const float**)&p;
    for (int i = 0; i < 23; ++i) pp[i] = (const float*)d_in[i];
    p.out = (float*)d_out; p.ws = (unsigned char*)d_ws;
    p.ph_lo = 0; p.ph_hi = NPHASE;
    (void)hipMemsetAsync((unsigned char*)d_ws + WS_CTL, 0, CTL_BYTES, stream);
    void* args[] = {&p};
    hipError_t e = hipLaunchCooperativeKernel((const void*)fwd_megakernel, dim3(grid_blocks), dim3(512), args, LDS_BYTES, stream);
    if (e != hipSuccess) fprintf(stderr, "cooperative launch failed: %s (grid %d)\n", hipGetErrorString(e), grid_blocks);
}
```

```cpp
#include <hip/hip_runtime.h>
#include <hip/hip_cooperative_groups.h>
#include <cstdio>
#include <cstdint>
namespace cg = cooperative_groups;

#define PROBE_REP 0
#define PROBE_SYNC 0
#define PROBE_MIX 0

#define LAS __attribute__((address_space(3)))
typedef unsigned short bf16_t;
typedef short bf16x8 __attribute__((ext_vector_type(8)));
typedef short s16x4 __attribute__((ext_vector_type(4)));
typedef float f32x4 __attribute__((ext_vector_type(4)));
typedef float f32x2 __attribute__((ext_vector_type(2)));
typedef float f32x16 __attribute__((ext_vector_type(16)));
typedef unsigned u32x4 __attribute__((ext_vector_type(4)));
typedef unsigned u32x2 __attribute__((ext_vector_type(2)));

constexpr int M = 16384, MCTX = 8192, D = 1024, FF = 2816, NGU = 2 * FF, NIN = 2304, NMOD = 9;
constexpr int NK_OFF = 16777216, NV_OFF = 25165824;
constexpr float EPS = 1e-6f;
constexpr float LOG2E = 1.4426950408889634f;

constexpr size_t MiB = 1u << 20;
constexpr size_t WS_MOD = 0;
constexpr size_t WS_CTL = 1 * MiB + 512 * 1024, CTL_BYTES = 16384;
constexpr size_t WS_PW = 1 * MiB + 256 * 1024;
constexpr size_t WS_SW = 1 * MiB;
constexpr size_t WS_CK = 2 * MiB;
constexpr size_t WS_CVT = 6 * MiB;
constexpr size_t WS_SSP = 10 * MiB;
constexpr size_t WS_BIAS = 11 * MiB;
constexpr size_t WS_SHB = 12 * MiB;
constexpr int NB = 13568;
constexpr size_t WS_W = 16 * MiB;
constexpr size_t W_GU_SZ = (size_t)NGU * D * 2, W_IN_SZ = (size_t)NIN * D * 2, W_D_SZ = (size_t)D * FF * 2, W_OUT_SZ = (size_t)D * D * 2;
constexpr size_t W_GU0 = 0, W_IN = W_GU_SZ, W_GU1 = W_IN + W_IN_SZ, W_D = W_GU1 + W_GU_SZ, W_OUT = W_D + 2 * W_D_SZ;
constexpr size_t W_LAYER = W_OUT + W_OUT_SZ;
constexpr size_t WS_H = 96 * MiB;
constexpr size_t WS_ACT = 128 * MiB;
constexpr size_t WS_ZA = 128 * MiB;
constexpr size_t WS_UT = 136 * MiB;
constexpr size_t WS_VGT = 144 * MiB;
constexpr size_t WS_Q = 152 * MiB;
constexpr size_t WS_K = 168 * MiB;
constexpr size_t WS_VT = 184 * MiB;
constexpr size_t WS_OB = 200 * MiB;
constexpr size_t WS_XB = 232 * MiB;
static_assert(WS_W + 2 * W_LAYER <= WS_H, "weights fit");

struct Params {
    const float *x_prompt, *x_sample, *cache_k, *cache_v, *c, *c_ctx, *ada_w, *ada_b, *norm_g;
    const float *w_gate, *w_up, *w_down, *w_in, *pool_w, *pool_scale, *q_norm_g, *k_norm_g, *na_rpb;
    const float *sg_vnorm_g, *sg_w, *sg_b, *out_norm_g, *w_out;
    float* out; unsigned char* ws;
    int ph_lo, ph_hi;
};

typedef __bf16 hbf16x2 __attribute__((ext_vector_type(2)));
__device__ __forceinline__ unsigned pk2(float lo, float hi) { const f32x2 v = {lo, hi}; const hbf16x2 b = __builtin_convertvector(v, hbf16x2); return __builtin_bit_cast(unsigned, b); }
__device__ __forceinline__ unsigned f2bf(float f) { return pk2(f, 0.f) & 0xffffu; }
typedef const __attribute__((address_space(4))) Params* KargPtr;
struct ECtx { KargPtr kp; int l, k; LAS unsigned char* lds_epi_; };
__device__ __forceinline__ float bf2f(unsigned short b) { return __builtin_bit_cast(float, (unsigned)b << 16); }
__device__ __forceinline__ float wave_sum(float v) {
#pragma unroll
    for (int o = 1; o < 64; o <<= 1) v += __shfl_xor(v, o);
    return v;
}
__device__ __forceinline__ float fast_sigmoid(float x) { return __builtin_amdgcn_rcpf(1.0f + __builtin_amdgcn_exp2f(-x * LOG2E)); }
__device__ __forceinline__ float silu_f(float x) { return x * fast_sigmoid(x); }
__device__ __forceinline__ float gelu_tanh(float x) { const float y = 0.7978845608028654f * (x + 0.044715f * x * x * x); return x * fast_sigmoid(2.0f * y); }
__device__ __forceinline__ int kind_of_row(int row) { return row < MCTX ? 0 : 1 + ((row - MCTX) >> 10); }

namespace pg8 {
constexpr int BM = 256, BK = 64, HALF = 128, HTB = HALF * BK * 2, STAGE_BYTES = 8 * HTB, NXCD = 8, WGM = 8;
__host__ __device__ __forceinline__ int lds_byte(int r, int c) { const int st = (r >> 4) * 2 + (c >> 5), rr = r & 15, cc = c & 31, ob = rr * 64 + cc * 2; return st * 1024 + (ob ^ (((ob >> 9) & 1) << 5)); }
__host__ __device__ __forceinline__ void stage_rc(int b, int& R, int& C) { const int st = b / 1024, sb = b % 1024, swz = sb ^ (((sb >> 9) & 1) << 5); R = (st >> 1) * 16 + swz / 64; C = (st & 1) * 32 + (swz % 64) / 2; }
struct Unit { int pm, pn; };
struct Gemm { const bf16_t* A; const bf16_t* Bt; int M, N, K; };
struct StaticOrder {
    int nM, nN, nwg, G, c; int exi, expm, expn;
    __device__ void init(int M_, int N_, int G_, int c_) { nM = M_ / BM; nN = N_ / BM; nwg = nM * nN; G = G_; c = c_; exi = -1; expm = 0; expn = 0; }
    __device__ bool next(int i, Unit& u) const {
        const long L = (long)i * G + c; if (L >= nwg) { if (i == exi) { u.pm = expm; u.pn = expn; return true; } return false; }
        int wgid = (int)L; { const int q = nwg / NXCD, r = nwg % NXCD, xcd = wgid % NXCD, off = wgid / NXCD; wgid = (xcd < r ? xcd * (q + 1) : r * (q + 1) + (xcd - r) * q) + off; }
        const int nig = WGM * nN, gid = wgid / nig, fm = gid * WGM, gsz = (nM - fm) < WGM ? (nM - fm) : WGM;
        u.pm = fm + ((wgid % nig) % gsz); u.pn = (wgid % nig) / gsz;
        if (nN == 9) u.pn = u.pn == 8 ? 0 : u.pn + 1;
        return true;
    }
};
template <class Epi>
__device__ __forceinline__ void gemm_phase(LAS unsigned char* lds, const int tid, const Gemm g, const StaticOrder& S, const Epi& E) {
    const int wid = __builtin_amdgcn_readfirstlane(tid >> 6), lane = tid & 63, wr = wid >> 2, wc = wid & 3, fr = lane & 15, fq = lane >> 4;
    const int K = g.K, nt = K / BK;
    unsigned voffA[2];
#pragma unroll
    for (int i = 0; i < 2; ++i) { int R, C; stage_rc(tid * 16 + i * 8192, R, C); voffA[i] = (unsigned)(R * K + C) * 2u; }
    const size_t kstep = (size_t)(BK * 2);
    const size_t hstep = (size_t)HALF * K * 2;
    const size_t tstep = 2 * hstep;
    const unsigned ldsw = (unsigned)wid * 1024u;
    const int aoff = lds_byte(wr * 64 + fr, fq * 8), boff = lds_byte(wc * 32 + fr, fq * 8);
#define PG8_SA(b, h) (((b) * 2 + (h)) * HTB)
#define PG8_SB(b, h) ((4 + (b) * 2 + (h)) * HTB)
#define PG8_STAGE(bufoff, gbase) do { _Pragma("unroll") for (int _i = 0; _i < 2; ++_i) \
        __builtin_amdgcn_global_load_lds((const unsigned*)((const char*)(gbase) + voffA[_i]), (LAS unsigned*)(lds + (bufoff) + ldsw + _i * 8192), 16, 0, 0); } while (0)
#define PG8_LDA(dst, b, h) do { _Pragma("unroll") for (int m = 0; m < 4; ++m) _Pragma("unroll") for (int k = 0; k < 2; ++k) dst[m][k] = *(const LAS bf16x8*)(lds + PG8_SA(b, h) + aoff + m * 2048 + k * 1024); } while (0)
#define PG8_LDB(dst, b, h) do { _Pragma("unroll") for (int n = 0; n < 2; ++n) _Pragma("unroll") for (int k = 0; k < 2; ++k) dst[n][k] = *(const LAS bf16x8*)(lds + PG8_SB(b, h) + boff + n * 2048 + k * 1024); } while (0)
#define PG8_MMA(ai, bj, At, Bt) do { __builtin_amdgcn_s_setprio(1); _Pragma("unroll") for (int m = 0; m < 4; ++m) _Pragma("unroll") for (int n = 0; n < 2; ++n) _Pragma("unroll") for (int k = 0; k < 2; ++k) \
        acc[ai][bj][m][n] = __builtin_amdgcn_mfma_f32_16x16x32_bf16(Bt[n][k], At[m][k], acc[ai][bj][m][n], 0, 0, 0); __builtin_amdgcn_s_setprio(0); } while (0)
#define PG8_WAIT_V(n) asm volatile("s_waitcnt vmcnt(" #n ")" ::: "memory")
#define PG8_WAIT_L(n) asm volatile("s_waitcnt lgkmcnt(" #n ")" ::: "memory")
#define PG8_BAR __builtin_amdgcn_s_barrier()
#define PG8_SCHED __builtin_amdgcn_sched_barrier(0)
    Unit cur, nxt; int ui = 0;
    if (!S.next(0, cur)) return;
    f32x4 acc[2][2][4][2];
#pragma unroll
    for (int a = 0; a < 2; ++a)
#pragma unroll
        for (int b = 0; b < 2; ++b)
#pragma unroll
            for (int m = 0; m < 4; ++m)
#pragma unroll
                for (int n = 0; n < 2; ++n) acc[a][b][m][n] = (f32x4){0.f, 0.f, 0.f, 0.f};
    bf16x8 At[4][2], B0[2][2], B1[2][2];
    const char* cA = (const char*)g.A + (size_t)cur.pm * tstep; const char* cB = (const char*)g.Bt + (size_t)cur.pn * tstep;
    PG8_STAGE(PG8_SB(0, 0), cB); PG8_STAGE(PG8_SB(0, 1), cB + hstep); PG8_STAGE(PG8_SA(0, 0), cA); PG8_STAGE(PG8_SA(0, 1), cA + hstep);
    if (wr == 1) PG8_BAR;
    PG8_WAIT_V(2); PG8_BAR;
    PG8_STAGE(PG8_SB(1, 0), cB + kstep); PG8_STAGE(PG8_SA(1, 0), cA + kstep); PG8_STAGE(PG8_SB(1, 1), cB + hstep + kstep);
    PG8_WAIT_V(6); PG8_BAR;
    for (;;) {
        const bool has_next = S.next(ui + 1, nxt);
        const char* nA = has_next ? (const char*)g.A + (size_t)nxt.pm * tstep : cA; const char* nB = has_next ? (const char*)g.Bt + (size_t)nxt.pn * tstep : cB;
        for (int t = 0; t < nt; t += 2) {
            const bool last = (t == nt - 2);
            const char* a1 = cA + (size_t)(t + 1) * kstep;
            const char* a2 = last ? nA : cA + (size_t)(t + 2) * kstep; const char* b2 = last ? nB : cB + (size_t)(t + 2) * kstep;
            const char* a3 = a2 + kstep; const char* b3 = b2 + kstep;
            PG8_LDB(B0, 0, 0); PG8_LDB(B1, 0, 1); PG8_SCHED; PG8_LDA(At, 0, 0); PG8_STAGE(PG8_SA(1, 1), a1 + hstep);
            PG8_WAIT_V(8); PG8_WAIT_L(0); PG8_BAR; PG8_MMA(0, 0, At, B0); PG8_MMA(0, 1, At, B1); PG8_BAR; PG8_SCHED;
            PG8_LDA(At, 0, 1); PG8_STAGE(PG8_SB(0, 0), b2); PG8_STAGE(PG8_SB(0, 1), b2 + hstep); PG8_STAGE(PG8_SA(0, 0), a2);
            PG8_WAIT_V(8); PG8_WAIT_L(0); PG8_BAR; PG8_MMA(1, 0, At, B0); PG8_MMA(1, 1, At, B1); PG8_BAR; PG8_SCHED;
            PG8_LDB(B0, 1, 0); PG8_LDB(B1, 1, 1); PG8_SCHED; PG8_LDA(At, 1, 0); PG8_STAGE(PG8_SA(0, 1), a2 + hstep);
            PG8_WAIT_V(8); PG8_WAIT_L(0); PG8_BAR; PG8_MMA(0, 0, At, B0); PG8_MMA(0, 1, At, B1); PG8_BAR; PG8_SCHED;
            PG8_LDA(At, 1, 1); PG8_STAGE(PG8_SB(1, 0), b3); PG8_STAGE(PG8_SB(1, 1), b3 + hstep); PG8_STAGE(PG8_SA(1, 0), a3);
            PG8_WAIT_V(8); PG8_WAIT_L(0); PG8_BAR; PG8_MMA(1, 0, At, B0); PG8_MMA(1, 1, At, B1); PG8_BAR; PG8_SCHED;
        }
        if (wr == 0) PG8_BAR;
        E(acc, cur, wr, wc, fr, fq);
        if (!has_next) break;
#pragma unroll
        for (int a = 0; a < 2; ++a)
#pragma unroll
            for (int b = 0; b < 2; ++b)
#pragma unroll
                for (int m = 0; m < 4; ++m)
#pragma unroll
                    for (int n = 0; n < 2; ++n) acc[a][b][m][n] = (f32x4){0.f, 0.f, 0.f, 0.f};
        cur = nxt; cA = nA; cB = nB; ++ui;
        if (wr == 1) PG8_BAR;
    }
    PG8_WAIT_V(0);
    PG8_BAR;
#undef PG8_SA
#undef PG8_SB
#undef PG8_STAGE
#undef PG8_LDA
#undef PG8_LDB
#undef PG8_MMA
#undef PG8_WAIT_V
#undef PG8_WAIT_L
#undef PG8_BAR
#undef PG8_SCHED
}
}

__device__ __forceinline__ float row_rstd(const float* ssp, int row) {
    const f32x4 a = *(const f32x4*)(ssp + (size_t)row * 4);
    return __builtin_amdgcn_rsqf(((a[0] + a[1]) + (a[2] + a[3])) * (1.0f / D) + EPS);
}
__device__ __forceinline__ float rstd_of(const f32x4 a) { return __builtin_amdgcn_rsqf(((a[0] + a[1]) + (a[2] + a[3])) * (1.0f / D) + EPS); }
struct EpiSwiglu {
    ECtx c;
    __device__ __forceinline__ void operator()(const f32x4 (&acc)[2][2][4][2], const pg8::Unit& u, int wr, int wc, int fr, int fq) const {
        unsigned char* ws = c.kp->ws;
        bf16_t* act = (bf16_t*)(ws + WS_ACT); const float* ssp = (const float*)(ws + WS_SSP);
        const float* bias = (const float*)(ws + WS_BIAS) + (size_t)c.l * 9 * NB + (c.k == 5 ? 7936 : 0);
        const int kind = u.pm < 32 ? 0 : 1 + ((u.pm - 32) >> 2);
        const float* bp = bias + (size_t)kind * NB + u.pn * 256 + wc * 32 + fq * 4;
        f32x4 bg[2], bu[2];
#pragma unroll
        for (int bj = 0; bj < 2; ++bj) { bg[bj] = *(const f32x4*)(bp + bj * 128); bu[bj] = *(const f32x4*)(bp + bj * 128 + 16); }
        const float* sbase = ssp + (size_t)(u.pm * 256 + wr * 64 + fr) * 4;
        f32x4 sn = *(const f32x4*)sbase;
#pragma unroll
        for (int ai = 0; ai < 2; ++ai)
#pragma unroll
            for (int m = 0; m < 4; ++m) {
                int row = u.pm * 256 + ai * 128 + wr * 64 + m * 16 + fr; asm volatile("" : "+v"(row));
                const float rs = rstd_of(sn);
                if (ai * 4 + m < 7) sn = *(const f32x4*)(sbase + (((m + 1) >> 2) + ai) * 512 + ((m + 1) & 3) * 64);
                bf16_t* rp = act + (size_t)row * FF + u.pn * 128 + wc * 32 + fq * 8;
                u32x4 w;
                { const f32x4 gg = acc[ai][0][m][0] * rs + bg[0], uu = acc[ai][0][m][1] * rs + bu[0];
                  w.x = pk2(silu_f(gg[0]) * uu[0], silu_f(gg[1]) * uu[1]); w.y = pk2(silu_f(gg[2]) * uu[2], silu_f(gg[3]) * uu[3]); }
                { const f32x4 gg = acc[ai][1][m][0] * rs + bg[1], uu = acc[ai][1][m][1] * rs + bu[1];
                  w.z = pk2(silu_f(gg[0]) * uu[0], silu_f(gg[1]) * uu[1]); w.w = pk2(silu_f(gg[2]) * uu[2], silu_f(gg[3]) * uu[3]); }
                *(u32x4*)rp = w;
            }
    }
};
struct EpiRes {
    ECtx c;
    __device__ __forceinline__ void operator()(const f32x4 (&acc)[2][2][4][2], const pg8::Unit& u, int wr, int wc, int fr, int fq) const {
        unsigned char* ws = c.kp->ws; float* xout = c.kp->out;
        const float* MOD = (const float*)(ws + WS_MOD); const float* modl = MOD + (size_t)c.l * 81 * 1024;
        const bool from_in = c.l == 0 && c.k == 1;
        const float* xin_ctx = c.kp->x_prompt; const float* xin_lat = c.kp->x_sample;
        const int gi = c.k == 4 ? 5 : (c.k == 1 ? 2 : 8); const float coef = c.k == 4 ? 1.0f : 0.5f;
        const int nsub = c.k == 4 ? 2 : (c.k == 1 ? 1 : 0), nl = c.k == 6 ? c.l + 1 : c.l;
        const float* ng = nl < 2 ? c.kp->norm_g + (size_t)(nl * 3 + nsub) * 1024 : nullptr;
        const float* nmod = MOD + (size_t)nl * 81 * 1024; const int nsc = 3 * nsub + 1;
        bf16_t* hn = (bf16_t*)(ws + WS_H); float* ssp = (float*)(ws + WS_SSP);
        LAS float* ssl = (LAS float*)c.lds_epi_;
        const int kind = u.pm < 32 ? 0 : 1 + ((u.pm - 32) >> 2);
        const float* gv = modl + (size_t)(kind * 9 + gi) * 1024;
        const int col0 = u.pn * 256 + wc * 32 + fq * 8;
        f32x4 gt[2][2], gs[2][2];
#pragma unroll
        for (int bj = 0; bj < 2; ++bj)
#pragma unroll
            for (int n = 0; n < 2; ++n) {
                gt[bj][n] = *(const f32x4*)(gv + col0 + bj * 128 + n * 4) * coef;
                if (ng) gs[bj][n] = *(const f32x4*)(ng + col0 + bj * 128 + n * 4) * (*(const f32x4*)(nmod + (size_t)(kind * 9 + nsc) * 1024 + col0 + bj * 128 + n * 4) + 1.0f);
            }
        const float* xin = u.pm < 32 ? xin_ctx : xin_lat;
        const int rbase = (u.pm < 32 ? u.pm : u.pm - 32) * 256;
        bf16_t* xb = (bf16_t*)(ws + WS_XB);
        const bool is_last = nl >= 2;
        u32x4 xnb[2];
        if (!from_in) { const bf16_t* xp0 = xb + (size_t)(u.pm * 256 + wr * 64 + fr) * D + col0;
#pragma unroll
            for (int bj = 0; bj < 2; ++bj) xnb[bj] = *(const u32x4*)(xp0 + bj * 128); }
#pragma unroll
        for (int ai = 0; ai < 2; ++ai)
#pragma unroll
            for (int m = 0; m < 4; ++m) {
                int rl = ai * 128 + wr * 64 + m * 16 + fr; asm volatile("" : "+v"(rl));
                const float* ip = xin + (size_t)(rbase + rl) * D + col0;
                float* op = xout + (size_t)(u.pm * 256 + rl) * D + col0;
                bf16_t* hp = hn + (size_t)(u.pm * 256 + rl) * D + col0;
                bf16_t* xp = xb + (size_t)(u.pm * 256 + rl) * D + col0;
                f32x4 xc[2][2];
                if (from_in) {
#pragma unroll
                    for (int bj = 0; bj < 2; ++bj)
#pragma unroll
                        for (int n = 0; n < 2; ++n) xc[bj][n] = *(const f32x4*)(ip + bj * 128 + n * 4);
                } else {
#pragma unroll
                    for (int bj = 0; bj < 2; ++bj)
#pragma unroll
                        for (int n = 0; n < 2; ++n) { const unsigned wx_ = n ? xnb[bj].z : xnb[bj].x, wy_ = n ? xnb[bj].w : xnb[bj].y;
                            xc[bj][n] = (f32x4){__builtin_bit_cast(float, wx_ << 16), __builtin_bit_cast(float, wx_ & 0xffff0000u), __builtin_bit_cast(float, wy_ << 16), __builtin_bit_cast(float, wy_ & 0xffff0000u)}; }
                    if (ai * 4 + m < 7) { const bf16_t* xpn = xp + (size_t)((m == 3 ? 128 - 48 : 16)) * D;
#pragma unroll
                        for (int bj = 0; bj < 2; ++bj) xnb[bj] = *(const u32x4*)(xpn + bj * 128); }
                }
                float ss = 0.f;
#pragma unroll
                for (int bj = 0; bj < 2; ++bj) {
                    const f32x4 x0 = xc[bj][0] + gt[bj][0] * acc[ai][bj][m][0], x1 = xc[bj][1] + gt[bj][1] * acc[ai][bj][m][1];
                    if (is_last) { *(f32x4*)(op + bj * 128) = x0; *(f32x4*)(op + bj * 128 + 4) = x1; }
                    else { u32x4 wx; wx.x = pk2(x0[0], x0[1]); wx.y = pk2(x0[2], x0[3]); wx.z = pk2(x1[0], x1[1]); wx.w = pk2(x1[2], x1[3]); *(u32x4*)(xp + bj * 128) = wx; }
                    if (ng) {
                        ss += ((x0[0] * x0[0] + x0[1] * x0[1]) + (x0[2] * x0[2] + x0[3] * x0[3])) + ((x1[0] * x1[0] + x1[1] * x1[1]) + (x1[2] * x1[2] + x1[3] * x1[3]));
                        const f32x4 h0 = x0 * gs[bj][0], h1 = x1 * gs[bj][1];
                        u32x4 wh; wh.x = pk2(h0[0], h0[1]); wh.y = pk2(h0[2], h0[3]); wh.z = pk2(h1[0], h1[1]); wh.w = pk2(h1[2], h1[3]);
                        *(u32x4*)(hp + bj * 128) = wh;
                    }
                }
                if (ng) {
                    ss += __shfl_xor(ss, 16); ss += __shfl_xor(ss, 32);
                    if (fq == 0) ssl[rl * 4 + wc] = ss;
                }
            }
        if (ng) {
            asm volatile("s_waitcnt lgkmcnt(0)" ::: "memory"); __builtin_amdgcn_s_barrier(); asm volatile("" ::: "memory");
            const int t = wr * 256 + wc * 64 + fq * 16 + fr;
            if (t < 256) { const f32x4 a = *(const LAS f32x4*)(ssl + t * 4); ssp[(size_t)(u.pm * 256 + t) * 4 + u.pn] = (a[0] + a[1]) + (a[2] + a[3]); }
        }
    }
};
struct EpiBias {
    ECtx c;
    __device__ __forceinline__ void operator()(const f32x4 (&acc)[2][2][4][2], const pg8::Unit& u, int wr, int wc, int fr, int fq) const {
        float* bias = (float*)(c.kp->ws + WS_BIAS) + (size_t)c.l * 9 * NB;
        const int which = u.pn < 22 ? 0 : (u.pn < 31 ? 1 : 2);
        if (wr != 0) return;
#pragma unroll
        for (int m = 0; m < 2; ++m) {
            const int kind = m * 16 + fr - 9 * which;
            if (kind >= 0 && kind < 9) {
#pragma unroll
                for (int bj = 0; bj < 2; ++bj)
#pragma unroll
                    for (int n = 0; n < 2; ++n) *(f32x4*)(bias + (size_t)kind * NB + u.pn * 256 + bj * 128 + wc * 32 + n * 16 + fq * 4) = acc[0][bj][m][n];
            }
        }
    }
};
struct EpiIn {
    ECtx c;
    __device__ __forceinline__ void operator()(const f32x4 (&acc)[2][2][4][2], const pg8::Unit& u, int wr, int wc, int fr, int fq) const {
        unsigned char* ws = c.kp->ws; float* out = c.kp->out; const int layer = c.l;
        const float* qg = c.kp->q_norm_g + layer * 64; const float* kg = c.kp->k_norm_g + layer * 64; const float* vng = c.kp->sg_vnorm_g + layer * 256;
        const float* ssp = (const float*)(ws + WS_SSP); const float* bias = (const float*)(ws + WS_BIAS) + (size_t)layer * 9 * NB + 5632;
        const int pn = u.pn;
        const int kind = u.pm < 32 ? 0 : 1 + ((u.pm - 32) >> 2);
        const float* sbase = ssp + (size_t)(u.pm * 256 + wr * 64 + fr) * 4;
        f32x4 sn = *(const f32x4*)sbase;
        f32x4 bz[2][2];
#pragma unroll
        for (int bj = 0; bj < 2; ++bj)
#pragma unroll
            for (int n = 0; n < 2; ++n) bz[bj][n] = *(const f32x4*)(bias + (size_t)kind * NB + pn * 256 + bj * 128 + wc * 32 + n * 16 + fq * 4);
#pragma unroll
        for (int ai = 0; ai < 2; ++ai)
#pragma unroll
            for (int m = 0; m < 4; ++m) {
                int row = u.pm * 256 + ai * 128 + wr * 64 + m * 16 + fr; asm volatile("" : "+v"(row));
                const float rs = rstd_of(sn);
                if (ai * 4 + m < 7) sn = *(const f32x4*)(sbase + (((m + 1) >> 2) + ai) * 512 + ((m + 1) & 3) * 64);
                f32x4 v[2][2];
#pragma unroll
                for (int bj = 0; bj < 2; ++bj)
#pragma unroll
                    for (int n = 0; n < 2; ++n) v[bj][n] = acc[ai][bj][m][n] * rs + bz[bj][n];
#define PK8(dst16, x0, x1) do { u32x4 w_; w_.x = pk2((x0)[0], (x0)[1]); w_.y = pk2((x0)[2], (x0)[3]); w_.z = pk2((x1)[0], (x1)[1]); w_.w = pk2((x1)[2], (x1)[3]); *(u32x4*)(dst16) = w_; } while (0)
                if (pn == 0) {
                    bf16_t* za = (bf16_t*)(ws + WS_ZA) + (size_t)row * 256 + wc * 64 + fq * 8;
#pragma unroll
                    for (int bj = 0; bj < 2; ++bj) PK8(za + bj * 32, v[bj][0], v[bj][1]);
                } else if (pn <= 4) {
                    const bool isk = pn >= 3; const int h = (isk ? pn - 3 : pn - 1) * 4 + wc;
                    bf16_t* qb = (bf16_t*)(ws + WS_Q); bf16_t* kb = (bf16_t*)(ws + WS_K);
                    float ss = 0.f;
#pragma unroll
                    for (int bj = 0; bj < 2; ++bj)
#pragma unroll
                        for (int n = 0; n < 2; ++n) ss += (v[bj][n][0] * v[bj][n][0] + v[bj][n][1] * v[bj][n][1]) + (v[bj][n][2] * v[bj][n][2] + v[bj][n][3] * v[bj][n][3]);
                    ss += __shfl_xor(ss, 16); ss += __shfl_xor(ss, 32);
                    const float rstd = __builtin_amdgcn_rsqf(ss * (1.0f / 64.0f) + EPS);
                    const float* gn = isk ? kg : qg;
                    bf16_t* dst = isk ? kb + ((size_t)h * M + (row & ~31)) * 64 + (fq >> 1) * 512 + (row & 31) * 16 + (fq & 1) * 8 : qb + ((size_t)h * M + row) * 64 + fq * 8;
#pragma unroll
                    for (int bj = 0; bj < 2; ++bj) {
                        const int dd = bj * 32 + fq * 8;
                        const float qs = isk ? rstd : rstd * (0.125f * LOG2E);
                        const f32x4 o0 = v[bj][0] * qs * *(const f32x4*)(gn + dd), o1 = v[bj][1] * qs * *(const f32x4*)(gn + dd + 4);
                        PK8(dst + (isk ? bj * 1024 : bj * 32), o0, o1);
                        if (isk && row < MCTX) { float* nk = out + NK_OFF + ((((size_t)(row >> 8) * 2 + layer) * 8 + h) * 256 + (row & 255)) * 64 + dd; *(f32x4*)nk = o0; *(f32x4*)(nk + 4) = o1; }
                    }
                } else if (pn <= 6) {
                    const int h = (pn - 5) * 4 + wc;
                    bf16_t* vt = (bf16_t*)(ws + WS_VT);
                    bf16_t* vrow = vt + ((size_t)h * M + (row & ~31)) * 64 + ((row >> 3) & 1) * 512 + ((row >> 4) & 1) * 8 + (row & 7) + fq * 128;
#pragma unroll
                    for (int bj = 0; bj < 2; ++bj)
#pragma unroll
                        for (int n = 0; n < 2; ++n) {
#pragma unroll
                            for (int j = 0; j < 4; ++j) vrow[bj * 1024 + n * 64 + j * 16] = (bf16_t)f2bf(v[bj][n][j]);
                            if (row < MCTX) *(f32x4*)(out + NV_OFF + ((((size_t)(row >> 8) * 2 + layer) * 8 + h) * 256 + (row & 255)) * 64 + bj * 32 + fq * 8 + n * 4) = v[bj][n];
                        }
                } else if (pn == 7) {
                    bf16_t* ut = (bf16_t*)(ws + WS_UT) + (size_t)row * 256 + wc * 64 + fq * 8;
#pragma unroll
                    for (int bj = 0; bj < 2; ++bj) {
                        f32x4 g0, g1;
#pragma unroll
                        for (int j = 0; j < 4; ++j) { g0[j] = gelu_tanh(v[bj][0][j]); g1[j] = gelu_tanh(v[bj][1][j]); }
                        PK8(ut + bj * 32, g0, g1);
                    }
                } else {
                    float ss = 0.f;
#pragma unroll
                    for (int bj = 0; bj < 2; ++bj)
#pragma unroll
                        for (int n = 0; n < 2; ++n) {
#pragma unroll
                            for (int j = 0; j < 4; ++j) { v[bj][n][j] = gelu_tanh(v[bj][n][j]); ss += v[bj][n][j] * v[bj][n][j]; }
                        }
                    ss += __shfl_xor(ss, 16); ss += __shfl_xor(ss, 32);
                    const float rstd = __builtin_amdgcn_rsqf(ss * (1.0f / 64.0f) + EPS);
                    bf16_t* vgt = (bf16_t*)(ws + WS_VGT);
                    bf16_t* vgrow = vgt + (size_t)(row >> 7) * 32768 + ((row >> 4) & 7) * 512 + ((row >> 3) & 1) * 8 + (row & 7) + wc * 8192 + fq * 128;
#pragma unroll
                    for (int bj = 0; bj < 2; ++bj)
#pragma unroll
                        for (int n = 0; n < 2; ++n) {
                            const f32x4 o = v[bj][n] * rstd * *(const f32x4*)(vng + wc * 64 + bj * 32 + fq * 8 + n * 4);
#pragma unroll
                            for (int j = 0; j < 4; ++j) vgrow[bj * 4096 + n * 64 + j * 16] = (bf16_t)f2bf(o[j]);
                        }
                }
#undef PK8
            }
    }
};

struct EpiAll {
    ECtx c0;
    __device__ __forceinline__ void operator()(const f32x4 (&acc)[2][2][4][2], const pg8::Unit& u, int wr, int wc, int fr, int fq) const {
        ECtx c = c0; asm volatile("" : "+s"(c.kp));
        if (u.pm < 0) { ECtx cb = c; cb.l = 1; pg8::Unit ub; ub.pm = 0; ub.pn = u.pn - 48; EpiBias{cb}(acc, ub, wr, wc, fr, fq); }
        else if (c.k == 0 || c.k == 5) EpiSwiglu{c}(acc, u, wr, wc, fr, fq); else if (c.k == 2) EpiIn{c}(acc, u, wr, wc, fr, fq); else if (c.k < 0) EpiBias{c}(acc, u, wr, wc, fr, fq); else EpiRes{c}(acc, u, wr, wc, fr, fq);
    }
};
struct Frame {
    LAS unsigned char* lds;
    int tid, lane, wave, G, bid;
};

__device__ __forceinline__ void transpose_item(const float* src  , int sstride, int K, bf16_t* WT, int n0, int k0, LAS float* scr, int lane) {
    float tv[32];
#pragma unroll
    for (int i = 0; i < 32; ++i) tv[i] = src[(size_t)(k0 + 2 * i + (lane >> 5)) * sstride];
#pragma unroll
    for (int i = 0; i < 32; ++i) scr[(2 * i + (lane >> 5)) * 33 + (lane & 31)] = tv[i];
    asm volatile("s_waitcnt lgkmcnt(0)" ::: "memory");
    const int c = lane & 7;
#pragma unroll
    for (int j = 0; j < 4; ++j) { const int n = (lane >> 3) + 8 * j; const LAS float* s = scr + (8 * c) * 33 + n;
        u32x4 o; o.x = pk2(s[0 * 33], s[1 * 33]); o.y = pk2(s[2 * 33], s[3 * 33]); o.z = pk2(s[4 * 33], s[5 * 33]); o.w = pk2(s[6 * 33], s[7 * 33]);
        *(u32x4*)(WT + (size_t)(n0 + n) * K + k0 + 8 * c) = o; }
    asm volatile("s_waitcnt lgkmcnt(0)" ::: "memory");
}

constexpr int CV_GU = 16 * 176, CV_D = 44 * 32, CV_IN = 16 * 72, CV_OUT = 16 * 32, CV_NA = 2 * CV_GU + CV_IN, CV_LAYER = CV_NA + 2 * CV_D + CV_OUT;
__device__ __forceinline__ void convert_items(const Params& p, Frame& F, int l, int lo, int hi, int widx, int nw) {
    LAS float* scr = (LAS float*)(F.lds + F.wave * 16896);
    unsigned char* wl = p.ws + WS_W + (size_t)l * W_LAYER;
    const int q = F.lane & 31;
    for (int it = lo + widx; it < hi; it += nw) {
        int r = it;
        if (r < 2 * CV_GU) {
            const int f = r / CV_GU; r %= CV_GU; const int kb = r / 176, nb = r % 176, n0 = nb * 32;
            const int tile = n0 >> 8, p0 = n0 & 255, ffcol = tile * 128 + 32 * ((p0 >> 5) & 3) + 8 * ((q & 15) >> 2) + 4 * (p0 >> 7) + (q & 3);
            const float* src = ((q >> 4) ? p.w_up : p.w_gate) + (size_t)(l * 2 + f) * D * FF + ffcol;
            transpose_item(src, FF, D, (bf16_t*)(wl + (f ? W_GU1 : W_GU0)), n0, kb * 64, scr, F.lane); continue; }
        r -= 2 * CV_GU;
        if (r < CV_IN) {
            const int kb = r / 72, nb = r % 72, n0 = nb * 32, p0 = n0 & 255;
            const int lcol = (n0 & ~255) + 64 * ((p0 >> 5) & 3) + 32 * (p0 >> 7) + 8 * ((q & 15) >> 2) + 4 * (q >> 4) + (q & 3);
            const float* src = p.w_in + (size_t)l * D * NIN + lcol;
            transpose_item(src, NIN, D, (bf16_t*)(wl + W_IN), n0, kb * 64, scr, F.lane); continue; }
        r -= CV_IN;
        if (r < 2 * CV_D) {
            const int f = r / CV_D; r %= CV_D; const int kb = r / 32, nb = r % 32, n0 = nb * 32;
            const float* src = p.w_down + (size_t)(l * 2 + f) * FF * D + n0 + (8 * ((q & 15) >> 2) + 4 * (q >> 4) + (q & 3));
            transpose_item(src, D, FF, (bf16_t*)(wl + W_D + f * W_D_SZ), n0, kb * 64, scr, F.lane); continue; }
        r -= 2 * CV_D;
        { const int kb = r / 32, nb = r % 32, n0 = nb * 32;
          const float* src = p.w_out + (size_t)l * D * D + n0 + (8 * ((q & 15) >> 2) + 4 * (q >> 4) + (q & 3));
          transpose_item(src, D, D, (bf16_t*)(wl + W_OUT), n0, kb * 64, scr, F.lane); }
    }
}

__device__ __forceinline__ void phase_prologue(const Params& p, Frame& F) {
    float* MOD = (float*)(p.ws + WS_MOD);
    for (int item = F.bid; item < 144; item += F.G) {
        const int l = item / 72, jc = item % 72;
        LAS float* sc = (LAS float*)F.lds; LAS float* red = sc + 9 * 1024;
        for (int i = F.tid; i < 9 * 1024; i += 512) { const int s = i >> 10, k = i & 1023; const float v = s == 0 ? p.c_ctx[k] : p.c[(s - 1) * 1024 + k]; sc[i] = silu_f(v); }
        __syncthreads();
        const float* w = p.ada_w + (size_t)l * 1024 * 9216 + (size_t)(F.wave * 128) * 9216 + jc * 128 + F.lane * 2;
        f32x2 acc[9];
#pragma unroll
        for (int s = 0; s < 9; ++s) acc[s] = (f32x2){0.f, 0.f};
        for (int k0 = 0; k0 < 128; k0 += 32) {
            f32x2 wv[32];
#pragma unroll
            for (int k = 0; k < 32; ++k) wv[k] = *(const f32x2*)(w + (size_t)(k0 + k) * 9216);
#pragma unroll
            for (int k = 0; k < 32; ++k) {
#pragma unroll
                for (int s = 0; s < 9; ++s) acc[s] += sc[s * 1024 + F.wave * 128 + k0 + k] * wv[k];
            }
        }
#pragma unroll
        for (int s = 0; s < 9; ++s) { red[(F.wave * 9 + s) * 128 + F.lane * 2] = acc[s].x; red[(F.wave * 9 + s) * 128 + F.lane * 2 + 1] = acc[s].y; }
        __syncthreads();
        for (int i = F.tid; i < 9 * 128; i += 512) { const int s = i >> 7, j = i & 127; float sum = p.ada_b[l * 9216 + jc * 128 + j];
#pragma unroll
            for (int w8 = 0; w8 < 8; ++w8) sum += red[(w8 * 9 + s) * 128 + j];
            MOD[(size_t)(l * 9 + s) * 9216 + jc * 128 + j] = sum;
            const int mi = jc >> 3;
            if (mi % 3 == 0) ((bf16_t*)(p.ws + WS_SHB))[((size_t)l * 256 + 9 * (mi / 3) + s) * 1024 + (jc & 7) * 128 + j] = (bf16_t)f2bf(sum); }
        __syncthreads();
    }
    const int gw = F.bid * 8 + F.wave, NGW = F.G * 8;
    LAS float* scr = (LAS float*)(F.lds + F.wave * 16896);
    { unsigned* z = (unsigned*)(p.ws + WS_SHB);
      for (int i = gw * 64 + F.lane; i < 2 * 229 * 512; i += NGW * 64) { const int l = i / (229 * 512), r = i % (229 * 512); z[((size_t)l * 256 + 27) * 512 + r] = 0u; } }
    { bf16_t* SW = (bf16_t*)(p.ws + WS_SW);
      for (int i = gw * 64 + F.lane; i < 2 * 4 * 128 * 128 / 2; i += NGW * 64) { const f32x2 v = *(const f32x2*)(p.sg_w + 2 * (size_t)i); ((unsigned*)SW)[i] = pk2(v.x, v.y); } }
    { bf16_t* PW = (bf16_t*)(p.ws + WS_PW);
      for (int i = gw * 64 + F.lane; i < 2 * 4 * 64 * 64; i += NGW * 64) { const int c = i & 63, d = (i >> 6) & 63, lg = i >> 12; PW[i] = (bf16_t)f2bf(p.pool_w[((size_t)lg * 64 + c) * 64 + d]); } }
    { bf16_t* CK = (bf16_t*)(p.ws + WS_CK); bf16_t* CVT = (bf16_t*)(p.ws + WS_CVT);
      const bool split = F.G == 256;
      const int cw = split ? gw - 144 * 8 : gw, cnw = split ? (256 - 144) * 8 : NGW;
      if (cw >= 0)
      for (int it = cw; it < 128 * 4; it += cnw) {
          const int mat = it >> 2, t0 = (it & 3) * 64;
          const float* ks = p.cache_k + ((size_t)mat * 256 + t0) * 64; const float* vs = p.cache_v + ((size_t)mat * 256 + t0) * 64;
          const int d = F.lane;
          for (int tq = 0; tq < 64; tq += 16) {
              float kv[16], vv[16];
#pragma unroll
              for (int t = 0; t < 16; ++t) { kv[t] = ks[(tq + t) * 64 + d]; vv[t] = vs[(tq + t) * 64 + d]; }
#pragma unroll
              for (int t = 0; t < 16; ++t) {
                  const int tt = t0 + tq + t, key = tt & 31; const size_t tb = ((size_t)mat * 8 + (tt >> 5)) * 2048;
                  CK[tb + ((d >> 4) * 32 + key) * 16 + (d & 15)] = (bf16_t)f2bf(kv[t]);
                  CVT[tb + (((d >> 5) * 2 + ((key >> 3) & 1)) * 32 + (d & 31)) * 16 + (key >> 4) * 8 + (key & 7)] = (bf16_t)f2bf(vv[t]);
              }
          }
      } }
    convert_items(p, F, 0, 0, CV_NA, gw, NGW);
    if (F.G != 256) { convert_items(p, F, 0, CV_NA, CV_LAYER, gw, NGW); convert_items(p, F, 1, 0, CV_LAYER, gw, NGW); }
}

__device__ __forceinline__ void phase_norm0(const Params& p, Frame& F) {
    bf16_t* H = (bf16_t*)(p.ws + WS_H); float* SSP = (float*)(p.ws + WS_SSP);
    const float* modl = (const float*)(p.ws + WS_MOD);
    const bool split = F.G == 256;
    if (split && F.bid < 53) return;
    const int gw = (split ? F.bid - 53 : F.bid) * 8 + F.wave, NGW = (split ? F.G - 53 : F.G) * 8;
    for (int r0 = gw * 8; r0 < M; r0 += NGW * 8) {
        const int kind = kind_of_row(r0);
        const float* sc = modl + (size_t)(kind * 9 + 1) * 1024;
        f32x4 gs[4];
#pragma unroll
        for (int j = 0; j < 4; ++j) { const int col = 4 * F.lane + 256 * j; gs[j] = *(const f32x4*)(p.norm_g + col) * (*(const f32x4*)(sc + col) + 1.0f); }
#pragma unroll 4
        for (int rr = 0; rr < 8; ++rr) {
            const int row = r0 + rr;
            const float* xr = row < MCTX ? p.x_prompt + (size_t)row * D : p.x_sample + (size_t)(row - MCTX) * D;
            f32x4 v[4]; float s = 0.f;
#pragma unroll
            for (int j = 0; j < 4; ++j) { v[j] = *(const f32x4*)(xr + 4 * F.lane + 256 * j); s += (v[j][0] * v[j][0] + v[j][1] * v[j][1]) + (v[j][2] * v[j][2] + v[j][3] * v[j][3]); }
            s = wave_sum(s);
            if (F.lane < 4) SSP[(size_t)row * 4 + F.lane] = F.lane == 0 ? s : 0.f;
#pragma unroll
            for (int j = 0; j < 4; ++j) { const f32x4 o = v[j] * gs[j]; u32x2 w; w.x = pk2(o[0], o[1]); w.y = pk2(o[2], o[3]);
                *(u32x2*)(H + (size_t)row * D + 4 * F.lane + 256 * j) = w; }
        }
    }
}

__device__ __forceinline__ float half_max(float v) {
    const auto rr = __builtin_amdgcn_permlane32_swap(__builtin_bit_cast(unsigned, v), __builtin_bit_cast(unsigned, v), false, false);
    return fmaxf(__builtin_bit_cast(float, (unsigned)rr[0]), __builtin_bit_cast(float, (unsigned)rr[1]));
}
__device__ __forceinline__ float half_sum(float v) {
    const auto rr = __builtin_amdgcn_permlane32_swap(__builtin_bit_cast(unsigned, v), __builtin_bit_cast(unsigned, v), false, false);
    return __builtin_bit_cast(float, (unsigned)rr[0]) + __builtin_bit_cast(float, (unsigned)rr[1]);
}
struct AttnState { f32x16 O0, O1; float m, l; };
struct KF { bf16x8 k[4]; };
struct VF { bf16x8 v[2][2]; };
__device__ __forceinline__ void load_k(KF& f, const bf16_t* Kp, int lane) {
    const int rho = lane & 31, key = 16 * ((rho >> 2) & 1) + 4 * (rho >> 3) + (rho & 3);
    const bf16_t* kp = Kp + key * 16 + (lane >> 5) * 8;
#pragma unroll
    for (int c = 0; c < 4; ++c) f.k[c] = *(const bf16x8*)(kp + 512 * c);
}
__device__ __forceinline__ void load_v(VF& f, const bf16_t* Vp, int lane) {
    const bf16_t* vp = Vp + (lane & 31) * 16 + (lane >> 5) * 8;
#pragma unroll
    for (int mb = 0; mb < 2; ++mb)
#pragma unroll
        for (int c = 0; c < 2; ++c) f.v[mb][c] = *(const bf16x8*)(vp + (mb * 2 + c) * 512);
}
template <bool LOCAL>
__device__ __forceinline__ f32x16 qk_part(const bf16x8 (&qf)[4], const KF& f, int lane, const LAS float* bl, int th, int qc, int cs) {
    const int g = lane >> 5;
    f32x16 S;
#pragma unroll
    for (int i = 0; i < 16; ++i) S[i] = 0.f;
#pragma unroll
    for (int c = 0; c < 4; ++c) S = __builtin_amdgcn_mfma_f32_32x32x16_bf16(f.k[c], qf[c], S, 0, 0, 0);
    if (LOCAL) {
        const LAS float* bp = bl + (63 + th * 32 + 16 * g - qc);
        const int rel0 = th * 32 + 16 * g - cs;
        float bv[16];
#pragma unroll
        for (int i = 0; i < 16; ++i) bv[i] = bp[i];
#pragma unroll
        for (int i = 0; i < 16; ++i) {
            const float pen = (unsigned)(rel0 + i) < 16u ? 0.f : -1e30f;
            S[i] = (S[i] + bv[i]) + pen;
        }
    }
    return S;
}
__device__ __forceinline__ void pv_part(AttnState& st, f32x16 S, const VF& f) {
    float mt = S[0];
#pragma unroll
    for (int i = 1; i < 16; ++i) mt = fmaxf(mt, S[i]);
    mt = half_max(mt);
    if (__any(mt - st.m > 8.0f)) {
        const float mn = fmaxf(st.m, mt);
        const float alpha = __builtin_amdgcn_exp2f(st.m - mn);
        st.m = mn; st.l *= alpha;
#pragma unroll
        for (int i = 0; i < 16; ++i) { st.O0[i] *= alpha; st.O1[i] *= alpha; }
    }
    float ps = 0.f;
#pragma unroll
    for (int i = 0; i < 16; ++i) { S[i] = __builtin_amdgcn_exp2f(S[i] - st.m); ps += S[i]; }
    st.l += ps;
    bf16x8 pf[2];
#pragma unroll
    for (int c = 0; c < 2; ++c) {
        u32x4 w; w.x = pk2(S[8 * c + 0], S[8 * c + 1]); w.y = pk2(S[8 * c + 2], S[8 * c + 3]); w.z = pk2(S[8 * c + 4], S[8 * c + 5]); w.w = pk2(S[8 * c + 6], S[8 * c + 7]);
        pf[c] = __builtin_bit_cast(bf16x8, w);
    }
#define VFR(mb, c) (f.v[mb][c])
    st.O0 = __builtin_amdgcn_mfma_f32_32x32x16_bf16(VFR(0, 0), pf[0], st.O0, 0, 0, 0);
    st.O0 = __builtin_amdgcn_mfma_f32_32x32x16_bf16(VFR(0, 1), pf[1], st.O0, 0, 0, 0);
    st.O1 = __builtin_amdgcn_mfma_f32_32x32x16_bf16(VFR(1, 0), pf[0], st.O1, 0, 0, 0);
    st.O1 = __builtin_amdgcn_mfma_f32_32x32x16_bf16(VFR(1, 1), pf[1], st.O1, 0, 0, 0);
#undef VFR
}
template <bool LOCAL>
__device__ __forceinline__ void attn_run(AttnState& st, const bf16x8 (&qf)[4], const bf16_t* K0, const bf16_t* V0, int ntiles, int lane,
                                         const LAS float* rpbL, int r, int start, int qc, int cs) {
    KF ka, kb; VF va, vb;
    load_k(ka, K0, lane); load_v(va, V0, lane);
    for (int t = 0; t < ntiles; t += 2) {
        const LAS float* bl = rpbL + (start + (t >> 1) - r + 7) * 128;
        load_k(kb, K0 + (size_t)(t + 1) * 2048, lane);
        f32x16 S = qk_part<LOCAL>(qf, ka, lane, bl, 0, qc, cs);
        load_v(vb, V0 + (size_t)(t + 1) * 2048, lane);
        pv_part(st, S, va);
        const int tn = t + 2 < ntiles ? t + 2 : 0;
        load_k(ka, K0 + (size_t)tn * 2048, lane);
        S = qk_part<LOCAL>(qf, kb, lane, bl, 1, qc, cs);
        load_v(va, V0 + (size_t)tn * 2048, lane);
        pv_part(st, S, vb);
    }
}
__device__ __forceinline__ void attn_finish(Frame& F, AttnState& st, int q0, int h, const float* gb  , bf16_t* OB) {
    const int g = F.lane >> 5, ql = F.lane & 31;
    const float lt = half_sum(st.l);
    const float inv = 1.0f / lt;
    float ss = 0.f;
#pragma unroll
    for (int i = 0; i < 16; ++i) { st.O0[i] *= inv; st.O1[i] *= inv; ss += st.O0[i] * st.O0[i] + st.O1[i] * st.O1[i]; }
    ss = half_sum(ss);
    LAS float* hs = (LAS float*)(F.lds + 61440);
    if (g == 0) hs[h * 32 + ql] = ss;
    __syncthreads();
    float tot = 0.f;
#pragma unroll
    for (int hh = 0; hh < 8; ++hh) tot += hs[hh * 32 + ql];
    const float rstd = __builtin_amdgcn_rsqf(tot * (1.0f / 512.0f) + EPS);
    bf16_t* orow = OB + (size_t)(q0 + ql) * D + 256 + h * 64;
#pragma unroll
    for (int mb = 0; mb < 2; ++mb)
#pragma unroll
        for (int i = 0; i < 4; ++i) {
            const int d = 32 * mb + 8 * i + 4 * g;
            const f32x4 gv = *(const f32x4*)(gb + h * 64 + d);
            float o[4];
#pragma unroll
            for (int j = 0; j < 4; ++j) o[j] = (mb == 0 ? st.O0[4 * i + j] : st.O1[4 * i + j]) * rstd * gv[j];
            u32x2 w; w.x = pk2(o[0], o[1]); w.y = pk2(o[2], o[3]);
            *(u32x2*)(orow + d) = w;
        }
    __syncthreads();
}

__device__ __forceinline__ void pool_unit(const Params& p, Frame& F, int l, int u, const bf16_t* ZA, const bf16_t* PWT, bf16_t* OB, const float* ong) {
    const int lane = F.lane, g2 = lane >> 5, ql = lane & 31, w = F.wave;
    const int row0 = u * 32;
    const int seq0 = row0 < MCTX ? (row0 & ~255) : MCTX + ((row0 - MCTX) & ~1023);
    const int L = row0 < MCTX ? 256 : 1024, tloc = row0 - seq0;
    LAS float* A = (LAS float*)F.lds;
    LAS float* P = A + 48 * 256;
    LAS float* part = P + 32 * 260;
    bf16x8 af[4];
    { const bf16_t* ap = PWT + ((size_t)(l * 4 + (w >> 1)) * 64 + 32 * (w & 1) + ql) * 64 + 8 * g2;
#pragma unroll
      for (int kc = 0; kc < 4; ++kc) af[kc] = *(const bf16x8*)(ap + 16 * kc); }
    {
        unsigned wd[12];
#pragma unroll
        for (int it = 0; it < 12; ++it) { const int i = F.tid + it * 512, rr = i >> 7, cp = i & 127, tl = tloc - 8 + rr;
            wd[it] = 0u; if (tl >= 0 && tl < L) wd[it] = *(const unsigned*)(ZA + (size_t)(seq0 + tl) * 256 + 2 * cp); }
#pragma unroll
        for (int it = 0; it < 12; ++it) { const int i = F.tid + it * 512, rr = i >> 7, cp = i & 127;
            A[rr * 256 + 2 * cp] = __builtin_bit_cast(float, wd[it] << 16); A[rr * 256 + 2 * cp + 1] = __builtin_bit_cast(float, wd[it] & 0xffff0000u); }
    }
    __syncthreads();
    {
        const int ch = F.tid & 255, thh = F.tid >> 8, gi = ch >> 6;
        float a[31];
#pragma unroll
        for (int i = 0; i < 31; ++i) a[i] = A[(16 * thh + i) * 256 + ch];
#define POOL_WIN(HALF) do { _Pragma("unroll") for (int t = 0; t < 16; ++t) { float sm = 0.f; _Pragma("unroll") for (int j = -HALF; j < HALF; ++j) sm += a[8 + t + j]; \
            const int tl = tloc + 16 * thh + t; const int lo = max(tl - HALF, 0), hi = min(tl + HALF, L); \
            P[(16 * thh + t) * 260 + ch] = sm * __builtin_amdgcn_rcpf((float)(hi - lo)) - a[8 + t]; } } while (0)
        if (gi == 0) POOL_WIN(1); else if (gi == 1) POOL_WIN(2); else if (gi == 2) POOL_WIN(4); else POOL_WIN(8);
#undef POOL_WIN
    }
    __syncthreads();
    f32x16 Dm;
#pragma unroll
    for (int i = 0; i < 16; ++i) Dm[i] = 0.f;
    { const LAS float* pp = P + ql * 260 + (w >> 1) * 64 + 8 * g2;
#pragma unroll
      for (int kc = 0; kc < 4; ++kc) {
          const f32x4 x0 = *(const LAS f32x4*)(pp + 16 * kc), x1 = *(const LAS f32x4*)(pp + 16 * kc + 4);
          u32x4 wd; wd.x = pk2(x0[0], x0[1]); wd.y = pk2(x0[2], x0[3]); wd.z = pk2(x1[0], x1[1]); wd.w = pk2(x1[2], x1[3]);
          Dm = __builtin_amdgcn_mfma_f32_32x32x16_bf16(af[kc], __builtin_bit_cast(bf16x8, wd), Dm, 0, 0, 0);
      } }
    float ss = 0.f;
#pragma unroll
    for (int i = 0; i < 4; ++i) { const f32x4 ps = *(const f32x4*)(p.pool_scale + l * 256 + 32 * w + 8 * i + 4 * g2);
#pragma unroll
        for (int j = 0; j < 4; ++j) { Dm[4 * i + j] *= ps[j]; ss += Dm[4 * i + j] * Dm[4 * i + j]; } }
    ss = half_sum(ss);
    if (g2 == 0) part[w * 32 + ql] = ss;
    __syncthreads();
    float tot = 0.f;
#pragma unroll
    for (int w8 = 0; w8 < 8; ++w8) tot += part[w8 * 32 + ql];
    const float rstd = __builtin_amdgcn_rsqf(tot * (1.0f / 256.0f) + EPS);
#pragma unroll
    for (int i = 0; i < 4; ++i) { const int oc = 32 * w + 8 * i + 4 * g2; const f32x4 gv = *(const f32x4*)(ong + oc);
        u32x2 wv; wv.x = pk2(Dm[4 * i] * rstd * gv[0], Dm[4 * i + 1] * rstd * gv[1]); wv.y = pk2(Dm[4 * i + 2] * rstd * gv[2], Dm[4 * i + 3] * rstd * gv[3]);
        *(u32x2*)(OB + (size_t)(row0 + ql) * D + oc) = wv; }
    __syncthreads();
}

__device__ __forceinline__ void chunk_unit(const Params& p, Frame& F, int l, int u, const bf16_t* UB, const bf16_t* VGT, const bf16_t* SW, bf16_t* OB, const float* ong) {
    const int lane = F.lane, g = lane >> 5, ql = lane & 31;
    const int row0 = u * 128, w = F.wave, tb = w & 3, chh = w >> 2;
    const int tok = row0 + 32 * tb + ql;
    LAS float* part = (LAS float*)F.lds;
    float outv[2][2][16]; float ss = 0.f;
#pragma unroll
    for (int gs = 0; gs < 2; ++gs) {
        const int gi = 2 * chh + gs;
        bf16x8 bw[8];
        const bf16_t* wp = SW + ((size_t)(l * 4 + gi) * 128 + 32 * tb + ql) * 128 + 8 * g;
#pragma unroll
        for (int kc = 0; kc < 8; ++kc) bw[kc] = *(const bf16x8*)(wp + 16 * kc);
        const float bsv = p.sg_b[(size_t)(l * 4 + gi) * 128 + 32 * tb + ql];
#pragma unroll
        for (int cb = 0; cb < 2; ++cb) {
            const int ch0 = 64 * gi + 32 * cb;
            const bf16_t* ap = VGT + ((size_t)(u * 8 + 2 * gi + cb) * 8) * 512 + ql * 16 + 8 * g;
            s16x4 uv[4];
#pragma unroll
            for (int i = 0; i < 4; ++i) uv[i] = *(const s16x4*)(UB + (size_t)tok * 256 + ch0 + 8 * i + 4 * g);
            f32x16 Dm;
#pragma unroll
            for (int i = 0; i < 16; ++i) Dm[i] = 0.f;
#pragma unroll
            for (int kc = 0; kc < 8; ++kc) { const bf16x8 af = *(const bf16x8*)(ap + 512 * kc); Dm = __builtin_amdgcn_mfma_f32_32x32x16_bf16(af, bw[kc], Dm, 0, 0, 0); }
#pragma unroll
            for (int i = 0; i < 4; ++i)
#pragma unroll
                for (int j = 0; j < 4; ++j) { const float o = bf2f((unsigned short)uv[i][j]) * (Dm[4 * i + j] + bsv); outv[gs][cb][4 * i + j] = o; ss += o * o; }
        }
    }
    ss = half_sum(ss);
    if (g == 0) part[chh * 128 + 32 * tb + ql] = ss;
    __syncthreads();
    const float tot = part[32 * tb + ql] + part[128 + 32 * tb + ql];
    const float rstd = __builtin_amdgcn_rsqf(tot * (1.0f / 256.0f) + EPS);
#pragma unroll
    for (int gs = 0; gs < 2; ++gs)
#pragma unroll
        for (int cb = 0; cb < 2; ++cb)
#pragma unroll
            for (int i = 0; i < 4; ++i) {
                const int ch = 64 * (2 * chh + gs) + 32 * cb + 8 * i + 4 * g;
                const f32x4 gv = *(const f32x4*)(ong + 768 + ch);
                u32x2 wv; wv.x = pk2(outv[gs][cb][4 * i] * rstd * gv[0], outv[gs][cb][4 * i + 1] * rstd * gv[1]); wv.y = pk2(outv[gs][cb][4 * i + 2] * rstd * gv[2], outv[gs][cb][4 * i + 3] * rstd * gv[3]);
                *(u32x2*)(OB + (size_t)tok * D + 768 + ch) = wv;
            }
    __syncthreads();
}

__device__ __forceinline__ void phase_mix(const Params& p, Frame& F, int l) {
    const int lane = F.lane, h = F.wave, g = lane >> 5, ql = lane & 31;
    const int vb = (F.G % 8 == 0) ? (F.bid % 8) * (F.G / 8) + F.bid / 8 : F.bid;
    {
    const bf16_t* QB = (const bf16_t*)(p.ws + WS_Q); const bf16_t* KB = (const bf16_t*)(p.ws + WS_K); const bf16_t* VT = (const bf16_t*)(p.ws + WS_VT);
    const bf16_t* CK = (const bf16_t*)(p.ws + WS_CK); const bf16_t* CVT = (const bf16_t*)(p.ws + WS_CVT);
    bf16_t* OB = (bf16_t*)(p.ws + WS_OB);
    const float* ong = p.out_norm_g + l * 1024;
    for (int u = vb; u < 256; u += F.G) {
        const int b = u >> 5, r = (u >> 1) & 15, qh = u & 1;
        const int q0 = MCTX + b * 1024 + r * 64 + qh * 32;
        LAS float* rpbL = (LAS float*)(F.lds + F.wave * 7680);
        for (int i = lane; i < 15 * 128; i += 64) rpbL[i] = 0.f;
        { float tv[8];
#pragma unroll
          for (int k = 0; k < 8; ++k) { const int i = lane + 64 * k; tv[k] = i < 465 ? p.na_rpb[((size_t)l * 8 + h) * 465 + i] : 0.f; }
#pragma unroll
          for (int k = 0; k < 8; ++k) { const int i = lane + 64 * k; if (i < 465) rpbL[(i / 31) * 128 + 48 + (i % 31)] = tv[k] * LOG2E; } }
        bf16x8 qf[4];
#pragma unroll
        for (int c = 0; c < 4; ++c) qf[c] = *(const bf16x8*)(QB + ((size_t)h * M + q0 + ql) * 64 + 16 * c + 8 * g);
        AttnState st;
#pragma unroll
        for (int i = 0; i < 16; ++i) { st.O0[i] = 0.f; st.O1[i] = 0.f; }
        st.m = -1e30f; st.l = 0.f;
        const bf16_t* ck = CK + (size_t)((b * 2 + l) * 8 + h) * 256 * 64; const bf16_t* cvt = CVT + (size_t)((b * 2 + l) * 8 + h) * 64 * 256;
        attn_run<false>(st, qf, ck, cvt, 8, lane, rpbL, 0, 0, 0, 0);
        const int start = min(max(r - 4, 0), 8);
        const int qc = qh * 32 + ql, cs = min(max(qc - 8, 0), 48);
        const size_t toff = ((size_t)h * M + MCTX + b * 1024 + start * 64) * 64;
        attn_run<true>(st, qf, KB + toff, VT + toff, 16, lane, rpbL, r, start, qc, cs);
        attn_finish(F, st, q0, h, ong + 256, OB);
    }
    for (int u = vb; u < 256; u += F.G) {
        const int b = u >> 3, qb = u & 7, q0 = b * 256 + qb * 32;
        bf16x8 qf[4];
#pragma unroll
        for (int c = 0; c < 4; ++c) qf[c] = *(const bf16x8*)(QB + ((size_t)h * M + q0 + ql) * 64 + 16 * c + 8 * g);
        AttnState st;
#pragma unroll
        for (int i = 0; i < 16; ++i) { st.O0[i] = 0.f; st.O1[i] = 0.f; }
        st.m = -1e30f; st.l = 0.f;
        const size_t toff = ((size_t)h * M + b * 256) * 64;
        attn_run<false>(st, qf, KB + toff, VT + toff, 8, lane, (const LAS float*)F.lds, 0, 0, 0, 0);
        attn_finish(F, st, q0, h, ong + 256, OB);
    }
    }
    const bf16_t* ZA = (const bf16_t*)(p.ws + WS_ZA); const bf16_t* UB = (const bf16_t*)(p.ws + WS_UT); const bf16_t* VGT = (const bf16_t*)(p.ws + WS_VGT);
    const bf16_t* SW = (const bf16_t*)(p.ws + WS_SW); const bf16_t* PWT = (const bf16_t*)(p.ws + WS_PW);
    bf16_t* OB = (bf16_t*)(p.ws + WS_OB);
    const float* ong = p.out_norm_g + l * 1024;
    if (F.G == 256) {
        if (F.bid < 128) { chunk_unit(p, F, l, F.bid, UB, VGT, SW, OB, ong); pool_unit(p, F, l, F.bid, ZA, PWT, OB, ong); }
        else { for (int i = 0; i < 3; ++i) pool_unit(p, F, l, 128 + (F.bid - 128) * 3 + i, ZA, PWT, OB, ong); }
    } else {
        for (int u = F.bid; u < 128; u += F.G) chunk_unit(p, F, l, u, UB, VGT, SW, OB, ong);
        for (int u = F.bid; u < 512; u += F.G) pool_unit(p, F, l, u, ZA, PWT, OB, ong);
    }
}

#define XB_TMO      128
#define XB_XCNT(j)  (256  + 64 * (j))
#define XB_XSUB(j)  (1280 + 64 * (j))
#define XB_XGEN(j)  (2304 + 64 * (j))
#define XB_TOP      3328
#define XB_TOPGEN   3392
#define XCD_BAR_WORDS 3456
#define XB_SPIN_CAP (1u << 18)
__device__ __forceinline__ unsigned xb_ld(unsigned* p)              { return __hip_atomic_load(p, __ATOMIC_RELAXED, __HIP_MEMORY_SCOPE_AGENT); }
__device__ __forceinline__ unsigned xb_add(unsigned* p, unsigned v) { return __hip_atomic_fetch_add(p, v, __ATOMIC_RELAXED, __HIP_MEMORY_SCOPE_AGENT); }
__device__ __forceinline__ unsigned xb_xcc_id() { return (unsigned)__builtin_amdgcn_s_getreg((3 << 11) | 20) & 0xFu; }
#define XB_SPIN(cond, bar) do { unsigned _sp = 0; while (cond) { __builtin_amdgcn_s_sleep(1); \
    if ((++_sp & 255u) == 0u) { if (xb_ld(&(bar)[XB_TMO])) break; if (_sp > XB_SPIN_CAP) { atomicAdd(&(bar)[XB_TMO], 1u); break; } } } } while (0)
struct XcdBarrier { unsigned* bar; unsigned x; volatile LAS unsigned* st; };
__device__ __forceinline__ XcdBarrier xcd_barrier_post(unsigned* bar, volatile LAS unsigned* st) {
    XcdBarrier b; b.bar = bar; b.x = xb_xcc_id(); b.st = st;
    if (threadIdx.x == 0) (void)xb_add(&bar[XB_XCNT(b.x)], 1u);
    return b;
}
__device__ __forceinline__ void xcd_barrier_complete(unsigned* bar, unsigned x, unsigned& nloc, unsigned& nx) {
    const unsigned G = gridDim.x * gridDim.y * gridDim.z;
    unsigned sum, cnt, mine, sp = 0u;
    for (;;) {
        sum = 0u; cnt = 0u; mine = 0u;
#pragma unroll
        for (unsigned j = 0; j < 16; ++j) { const unsigned c = xb_ld(&bar[XB_XCNT(j)]); sum += c; cnt += (c > 0u) ? 1u : 0u; mine = (j == x) ? c : mine; }
        if (sum == G) break;
        __builtin_amdgcn_s_sleep(1);
        if ((++sp & 255u) == 0u) { if (xb_ld(&bar[XB_TMO])) break; if (sp > XB_SPIN_CAP) { atomicAdd(&bar[XB_TMO], 1u); break; } }
    }
    nloc = mine > 0u ? mine : 1u; nx = cnt > 0u ? cnt : 1u;
}
__device__ __forceinline__ void xcd_barrier(const XcdBarrier& b) {
    asm volatile("s_waitcnt vmcnt(0)" ::: "memory");
    __syncthreads();
    if (threadIdx.x == 0) {
        unsigned* bar = b.bar;
        __builtin_amdgcn_s_waitcnt(0);
        unsigned nloc = b.st[0], nx = b.st[1];
        if (nloc == 0u) { xcd_barrier_complete(bar, b.x, nloc, nx); b.st[0] = nloc; b.st[1] = nx; }
        const unsigned old = xb_add(&bar[XB_XSUB(b.x)], 1u);
        const unsigned gen = old / nloc;
        if (old + 1u == (gen + 1u) * nloc) {
            __builtin_amdgcn_fence(__ATOMIC_RELEASE, "agent");
            asm volatile("s_waitcnt vmcnt(0)" ::: "memory");
            const unsigned og = xb_add(&bar[XB_TOP], 1u);
            const unsigned tg = og / nx;
            if (og + 1u == (tg + 1u) * nx) xb_add(&bar[XB_TOPGEN], 1u);
            else XB_SPIN(xb_ld(&bar[XB_TOPGEN]) == tg, bar);
            __builtin_amdgcn_fence(__ATOMIC_ACQUIRE, "agent");
            xb_add(&bar[XB_XGEN(b.x)], 1u);
            asm volatile("s_waitcnt vmcnt(0)" ::: "memory");
        } else {
            XB_SPIN(xb_ld(&bar[XB_XGEN(b.x)]) == gen, bar);
            __builtin_amdgcn_fence(__ATOMIC_ACQUIRE, "agent");
            asm volatile("s_waitcnt vmcnt(0)" ::: "memory");
        }
    }
    __syncthreads();
}

constexpr int LDS_MISC = 135168;
constexpr int LDS_BYTES = LDS_MISC + 64;
constexpr int NPHASE = 16;

__global__ void __launch_bounds__(512, 2) fwd_megakernel(Params p_in) {
    extern __shared__ __attribute__((aligned(16))) unsigned char lds_raw[];
    cg::grid_group grid = cg::this_grid();
    { volatile LAS unsigned* st0 = (volatile LAS unsigned*)((LAS unsigned char*)lds_raw + LDS_MISC); if (threadIdx.x < 16) st0[threadIdx.x] = 0u; }
    __syncthreads();
    (void)xcd_barrier_post((unsigned*)(p_in.ws + WS_CTL), (volatile LAS unsigned*)((LAS unsigned char*)lds_raw + LDS_MISC));
#define XBAR() do { XcdBarrier xb_; xb_.bar = (unsigned*)(p_in.ws + WS_CTL); xb_.x = xb_xcc_id(); xb_.st = (volatile LAS unsigned*)((LAS unsigned char*)lds_raw + LDS_MISC); xcd_barrier(xb_); } while (0)
    if (p_in.ph_lo < 0) grid.sync();
    int rep_ = 0;
    int wave_s = __builtin_amdgcn_readfirstlane((int)threadIdx.x >> 6);
    KargPtr kp4 = (KargPtr)__builtin_amdgcn_kernarg_segment_ptr();
    const int ph_hi_ = p_in.ph_hi;
#pragma nounroll
    for (int ph = p_in.ph_lo; ph < ph_hi_; ++ph) {
        asm volatile("" : "+s"(wave_s));
        int lane_ = (int)__builtin_amdgcn_mbcnt_hi(~0u, __builtin_amdgcn_mbcnt_lo(~0u, 0u)); asm volatile("" : "+v"(lane_));
        int tid_ = wave_s * 64 + lane_;
        asm volatile("" : "+s"(kp4));
#if defined(__HIP_DEVICE_COMPILE__)
        const Params p = *kp4;
#else
        const Params p = p_in;
#endif
        int bid_ = blockIdx.x; asm volatile("" : "+s"(bid_));
        unsigned lds0 = 0; asm volatile("" : "+s"(lds0));
        Frame F;
        F.lds = (LAS unsigned char*)lds_raw + lds0;
        F.tid = tid_; F.lane = F.tid & 63; F.wave = __builtin_amdgcn_readfirstlane(F.tid >> 6);
        F.G = gridDim.x; F.bid = bid_;
        const float* MOD = (const float*)(p.ws + WS_MOD);
        bf16_t* H = (bf16_t*)(p.ws + WS_H); bf16_t* ACT = (bf16_t*)(p.ws + WS_ACT); bf16_t* OB = (bf16_t*)(p.ws + WS_OB);
        float* X = p.out;
        if (ph == 0) {
#if !defined(MASK) || ((MASK>>0)&1)
            phase_prologue(p, F);
#endif
        } else {
            const int l = ph == 1 ? 0 : (ph - 2) / 7, k = ph == 1 ? -1 : (ph - 2) % 7;
            const float* modl = MOD + (size_t)l * 81 * 1024;
            unsigned char* wl = p.ws + WS_W + (size_t)l * W_LAYER;
            if (k == 3) {
#if !defined(MASK) || ((MASK>>5)&1)
                phase_mix(p, F, l);
#endif
            } else {
#if !defined(MASK) || ((MASK>>2)&1)
                EpiAll E; E.c0 = ECtx{kp4, l, k, F.lds + 131072};
                pg8::Gemm g; int N;
                if (k == -1) { g = pg8::Gemm{(const bf16_t*)(p.ws + WS_SHB), (const bf16_t*)(p.ws + WS_W), 256, NB, D}; N = NB; }
                else if (k == 0 || k == 5) { g = pg8::Gemm{H, (const bf16_t*)(wl + (k == 0 ? W_GU0 : W_GU1)), M, NGU, D}; N = NGU; }
                else if (k == 4) { g = pg8::Gemm{OB, (const bf16_t*)(wl + W_OUT), M, D, D}; N = D; }
                else if (k == 2) { g = pg8::Gemm{H, (const bf16_t*)(wl + W_IN), M, NIN, D}; N = NIN; }
                else { const int f = k == 1 ? 0 : 1; g = pg8::Gemm{ACT, (const bf16_t*)(wl + W_D + f * W_D_SZ), M, D, FF}; N = D; }
                pg8::StaticOrder S;
                const bool full = F.G == 256;
                if (k == -1) {
                    const int lb = F.bid < 53 ? 0 : 1;
                    g.A = (const bf16_t*)(p.ws + WS_SHB) + (size_t)lb * 256 * 1024; g.Bt = (const bf16_t*)(p.ws + WS_W + (size_t)lb * W_LAYER); E.c0.l = lb;
                    S.init(256, NB, 53, F.bid % 53);
                    if (F.bid >= (full ? 53 : 106)) S.nwg = 0;
                } else {
                    S.init(M, N, F.G, F.bid);
                    if (full && l == 0 && k == 5 && F.bid >= 203) { S.exi = 5; S.expm = -167; S.expn = 48 + (F.bid - 203); }
                }
                pg8::gemm_phase<EpiAll>(F.lds, F.tid, g, S, E);
                if (k == -1) phase_norm0(p, F);
                if (full && l == 0) {
                    if (k == 0 && F.bid >= 128) convert_items(p, F, 0, CV_NA, CV_LAYER, (F.bid - 128) * 8 + F.wave, 128 * 8);
                    if (k == 2 && F.bid >= 64) convert_items(p, F, 1, 0, CV_NA, (F.bid - 64) * 8 + F.wave, 192 * 8);
                    if (k == 5 && F.bid >= 128 && F.bid < 203) convert_items(p, F, 1, CV_NA, CV_LAYER, (F.bid - 128) * 8 + F.wave, 75 * 8);
                }
#endif
            }
        }
#if PROBE_REP
        { const int kind_ = ph < 2 ? ph : 2 + (ph - 2) % 7;
          if (((PROBE_REP >> kind_) & 1) && rep_ == 0) { rep_ = 1; XBAR(); --ph; continue; }
          rep_ = 0; }
#endif
        if (ph + 1 < ph_hi_) XBAR();
    }
    for (int i_ = 0; i_ < PROBE_SYNC; ++i_) XBAR();
}

extern "C" void kernel_launch(void* const* d_in, const int* in_sizes, int n_in, void* d_out, int out_size, void* d_ws, size_t ws_size, hipStream_t stream) {
    static int grid_blocks = 0;
    if (!grid_blocks) {
        int dev = 0, cus = 0, per_cu = 0;
        hipGetDevice(&dev);
        hipDeviceGetAttribute(&cus, hipDeviceAttributeMultiprocessorCount, dev);
        hipFuncSetAttribute((const void*)fwd_megakernel, hipFuncAttributeMaxDynamicSharedMemorySize, LDS_BYTES);
        hipOccupancyMaxActiveBlocksPerMultiprocessor(&per_cu, (const void*)fwd_megakernel, 512, LDS_BYTES);
        if (per_cu < 1) { fprintf(stderr, "kernel_launch: occupancy query reports %d blocks per CU\n", per_cu); per_cu = 1; }
        grid_blocks = cus;
        (void)hipGetLastError();
    }
    Params p{};
    const float** pp = (const float**)&p;
    for (int i = 0; i < 23; ++i) pp[i] = (const float*)d_in[i];
    p.out = (float*)d_out; p.ws = (unsigned char*)d_ws;
    p.ph_lo = 0; p.ph_hi = NPHASE;
    (void)hipMemsetAsync((unsigned char*)d_ws + WS_CTL, 0, CTL_BYTES, stream);
    void* args[] = {&p};
    hipError_t e = hipLaunchCooperativeKernel((const void*)fwd_megakernel, dim3(grid_blocks), dim3(512), args, LDS_BYTES, stream);
    if (e != hipSuccess) fprintf(stderr, "cooperative launch failed: %s (grid %d)\n", hipGetErrorString(e), grid_blocks);
}
```

```cpp
#include <hip/hip_runtime.h>
#include <hip/hip_cooperative_groups.h>
#include <cstdio>
#include <cstdint>
namespace cg = cooperative_groups;

#define PROBE_REP 0
#define PROBE_SYNC 0
#define PROBE_MIX 0

#define LAS __attribute__((address_space(3)))
typedef unsigned short bf16_t;
typedef short bf16x8 __attribute__((ext_vector_type(8)));
typedef short s16x4 __attribute__((ext_vector_type(4)));
typedef float f32x4 __attribute__((ext_vector_type(4)));
typedef float f32x2 __attribute__((ext_vector_type(2)));
typedef float f32x16 __attribute__((ext_vector_type(16)));
typedef unsigned u32x4 __attribute__((ext_vector_type(4)));
typedef unsigned u32x2 __attribute__((ext_vector_type(2)));

constexpr int M = 16384, MCTX = 8192, D = 1024, FF = 2816, NGU = 2 * FF, NIN = 2304, NMOD = 9;
constexpr int NK_OFF = 16777216, NV_OFF = 25165824;
constexpr float EPS = 1e-6f;
constexpr float LOG2E = 1.4426950408889634f;

constexpr size_t MiB = 1u << 20;
constexpr size_t WS_MOD = 0;
constexpr size_t WS_CTL = 1 * MiB + 512 * 1024, CTL_BYTES = 16384;
constexpr size_t WS_PW = 1 * MiB + 256 * 1024;
constexpr size_t WS_SW = 1 * MiB;
constexpr size_t WS_CK = 2 * MiB;
constexpr size_t WS_CVT = 6 * MiB;
constexpr size_t WS_SSP = 10 * MiB;
constexpr size_t WS_BIAS = 11 * MiB;
constexpr size_t WS_SHB = 12 * MiB;
constexpr int NB = 13568;
constexpr size_t WS_W = 16 * MiB;
constexpr size_t W_GU_SZ = (size_t)NGU * D * 2, W_IN_SZ = (size_t)NIN * D * 2, W_D_SZ = (size_t)D * FF * 2, W_OUT_SZ = (size_t)D * D * 2;
constexpr size_t W_GU0 = 0, W_IN = W_GU_SZ, W_GU1 = W_IN + W_IN_SZ, W_D = W_GU1 + W_GU_SZ, W_OUT = W_D + 2 * W_D_SZ;
constexpr size_t W_LAYER = W_OUT + W_OUT_SZ;
constexpr size_t WS_H = 96 * MiB;
constexpr size_t WS_ACT = 128 * MiB;
constexpr size_t WS_ZA = 128 * MiB;
constexpr size_t WS_UT = 136 * MiB;
constexpr size_t WS_VGT = 144 * MiB;
constexpr size_t WS_Q = 152 * MiB;
constexpr size_t WS_K = 168 * MiB;
constexpr size_t WS_VT = 184 * MiB;
constexpr size_t WS_OB = 200 * MiB;
constexpr size_t WS_XB = 232 * MiB;
static_assert(WS_W + 2 * W_LAYER <= WS_H, "weights fit");

struct Params {
    const float *x_prompt, *x_sample, *cache_k, *cache_v, *c, *c_ctx, *ada_w, *ada_b, *norm_g;
    const float *w_gate, *w_up, *w_down, *w_in, *pool_w, *pool_scale, *q_norm_g, *k_norm_g, *na_rpb;
    const float *sg_vnorm_g, *sg_w, *sg_b, *out_norm_g, *w_out;
    float* out; unsigned char* ws;
    int ph_lo, ph_hi;
};

typedef __bf16 hbf16x2 __attribute__((ext_vector_type(2)));
__device__ __forceinline__ unsigned pk2(float lo, float hi) { const f32x2 v = {lo, hi}; const hbf16x2 b = __builtin_convertvector(v, hbf16x2); return __builtin_bit_cast(unsigned, b); }
__device__ __forceinline__ unsigned f2bf(float f) { return pk2(f, 0.f) & 0xffffu; }
typedef const __attribute__((address_space(4))) Params* KargPtr;
struct ECtx { KargPtr kp; int l, k; LAS unsigned char* lds_epi_; };
__device__ __forceinline__ float bf2f(unsigned short b) { return __builtin_bit_cast(float, (unsigned)b << 16); }
__device__ __forceinline__ float wave_sum(float v) {
#pragma unroll
    for (int o = 1; o < 64; o <<= 1) v += __shfl_xor(v, o);
    return v;
}
__device__ __forceinline__ float fast_sigmoid(float x) { return __builtin_amdgcn_rcpf(1.0f + __builtin_amdgcn_exp2f(-x * LOG2E)); }
__device__ __forceinline__ float silu_f(float x) { return x * fast_sigmoid(x); }
__device__ __forceinline__ float gelu_tanh(float x) { const float y = 0.7978845608028654f * (x + 0.044715f * x * x * x); return x * fast_sigmoid(2.0f * y); }
__device__ __forceinline__ int kind_of_row(int row) { return row < MCTX ? 0 : 1 + ((row - MCTX) >> 10); }

namespace pg8 {
constexpr int BM = 256, BK = 64, HALF = 128, HTB = HALF * BK * 2, STAGE_BYTES = 8 * HTB, NXCD = 8, WGM = 8;
__host__ __device__ __forceinline__ int lds_byte(int r, int c) { const int st = (r >> 4) * 2 + (c >> 5), rr = r & 15, cc = c & 31, ob = rr * 64 + cc * 2; return st * 1024 + (ob ^ (((ob >> 9) & 1) << 5)); }
__host__ __device__ __forceinline__ void stage_rc(int b, int& R, int& C) { const int st = b / 1024, sb = b % 1024, swz = sb ^ (((sb >> 9) & 1) << 5); R = (st >> 1) * 16 + swz / 64; C = (st & 1) * 32 + (swz % 64) / 2; }
struct Unit { int pm, pn; };
struct Gemm { const bf16_t* A; const bf16_t* Bt; int M, N, K; };
struct StaticOrder {
    int nM, nN, nwg, G, c; int exi, expm, expn;
    __device__ void init(int M_, int N_, int G_, int c_) { nM = M_ / BM; nN = N_ / BM; nwg = nM * nN; G = G_; c = c_; exi = -1; expm = 0; expn = 0; }
    __device__ bool next(int i, Unit& u) const {
        const long L = (long)i * G + c; if (L >= nwg) { if (i == exi) { u.pm = expm; u.pn = expn; return true; } return false; }
        int wgid = (int)L; { const int q = nwg / NXCD, r = nwg % NXCD, xcd = wgid % NXCD, off = wgid / NXCD; wgid = (xcd < r ? xcd * (q + 1) : r * (q + 1) + (xcd - r) * q) + off; }
        const int nig = WGM * nN, gid = wgid / nig, fm = gid * WGM, gsz = (nM - fm) < WGM ? (nM - fm) : WGM;
        u.pm = fm + ((wgid % nig) % gsz); u.pn = (wgid % nig) / gsz;
        if (nN == 9) u.pn = u.pn == 8 ? 0 : u.pn + 1;
        return true;
    }
};
template <class Epi>
__device__ __forceinline__ void gemm_phase(LAS unsigned char* lds, const int tid, const Gemm g, const StaticOrder& S, const Epi& E) {
    const int wid = __builtin_amdgcn_readfirstlane(tid >> 6), lane = tid & 63, wr = wid >> 2, wc = wid & 3, fr = lane & 15, fq = lane >> 4;
    const int K = g.K, nt = K / BK;
    unsigned voffA[2];
#pragma unroll
    for (int i = 0; i < 2; ++i) { int R, C; stage_rc(tid * 16 + i * 8192, R, C); voffA[i] = (unsigned)(R * K + C) * 2u; }
    const size_t kstep = (size_t)(BK * 2);
    const size_t hstep = (size_t)HALF * K * 2;
    const size_t tstep = 2 * hstep;
    const unsigned ldsw = (unsigned)wid * 1024u;
    const int aoff = lds_byte(wr * 64 + fr, fq * 8), boff = lds_byte(wc * 32 + fr, fq * 8);
#define PG8_SA(b, h) (((b) * 2 + (h)) * HTB)
#define PG8_SB(b, h) ((4 + (b) * 2 + (h)) * HTB)
#define PG8_STAGE(bufoff, gbase) do { _Pragma("unroll") for (int _i = 0; _i < 2; ++_i) \
        __builtin_amdgcn_global_load_lds((const unsigned*)((const char*)(gbase) + voffA[_i]), (LAS unsigned*)(lds + (bufoff) + ldsw + _i * 8192), 16, 0, 0); } while (0)
#define PG8_LDA(dst, b, h) do { _Pragma("unroll") for (int m = 0; m < 4; ++m) _Pragma("unroll") for (int k = 0; k < 2; ++k) dst[m][k] = *(const LAS bf16x8*)(lds + PG8_SA(b, h) + aoff + m * 2048 + k * 1024); } while (0)
#define PG8_LDB(dst, b, h) do { _Pragma("unroll") for (int n = 0; n < 2; ++n) _Pragma("unroll") for (int k = 0; k < 2; ++k) dst[n][k] = *(const LAS bf16x8*)(lds + PG8_SB(b, h) + boff + n * 2048 + k * 1024); } while (0)
#define PG8_MMA(ai, bj, At, Bt) do { __builtin_amdgcn_s_setprio(1); _Pragma("unroll") for (int m = 0; m < 4; ++m) _Pragma("unroll") for (int n = 0; n < 2; ++n) _Pragma("unroll") for (int k = 0; k < 2; ++k) \
        acc[ai][bj][m][n] = __builtin_amdgcn_mfma_f32_16x16x32_bf16(Bt[n][k], At[m][k], acc[ai][bj][m][n], 0, 0, 0); __builtin_amdgcn_s_setprio(0); } while (0)
#define PG8_WAIT_V(n) asm volatile("s_waitcnt vmcnt(" #n ")" ::: "memory")
#define PG8_WAIT_L(n) asm volatile("s_waitcnt lgkmcnt(" #n ")" ::: "memory")
#define PG8_BAR __builtin_amdgcn_s_barrier()
#define PG8_SCHED __builtin_amdgcn_sched_barrier(0)
    Unit cur, nxt; int ui = 0;
    if (!S.next(0, cur)) return;
    f32x4 acc[2][2][4][2];
#pragma unroll
    for (int a = 0; a < 2; ++a)
#pragma unroll
        for (int b = 0; b < 2; ++b)
#pragma unroll
            for (int m = 0; m < 4; ++m)
#pragma unroll
                for (int n = 0; n < 2; ++n) acc[a][b][m][n] = (f32x4){0.f, 0.f, 0.f, 0.f};
    bf16x8 At[4][2], B0[2][2], B1[2][2];
    const char* cA = (const char*)g.A + (size_t)cur.pm * tstep; const char* cB = (const char*)g.Bt + (size_t)cur.pn * tstep;
    PG8_STAGE(PG8_SB(0, 0), cB); PG8_STAGE(PG8_SB(0, 1), cB + hstep); PG8_STAGE(PG8_SA(0, 0), cA); PG8_STAGE(PG8_SA(0, 1), cA + hstep);
    if (wr == 1) PG8_BAR;
    PG8_WAIT_V(2); PG8_BAR;
    PG8_STAGE(PG8_SB(1, 0), cB + kstep); PG8_STAGE(PG8_SA(1, 0), cA + kstep); PG8_STAGE(PG8_SB(1, 1), cB + hstep + kstep);
    PG8_WAIT_V(6); PG8_BAR;
    for (;;) {
        const bool has_next = S.next(ui + 1, nxt);
        const char* nA = has_next ? (const char*)g.A + (size_t)nxt.pm * tstep : cA; const char* nB = has_next ? (const char*)g.Bt + (size_t)nxt.pn * tstep : cB;
        for (int t = 0; t < nt; t += 2) {
            const bool last = (t == nt - 2);
            const char* a1 = cA + (size_t)(t + 1) * kstep;
            const char* a2 = last ? nA : cA + (size_t)(t + 2) * kstep; const char* b2 = last ? nB : cB + (size_t)(t + 2) * kstep;
            const char* a3 = a2 + kstep; const char* b3 = b2 + kstep;
            PG8_LDB(B0, 0, 0); PG8_LDB(B1, 0, 1); PG8_SCHED; PG8_LDA(At, 0, 0); PG8_STAGE(PG8_SA(1, 1), a1 + hstep);
            PG8_WAIT_V(8); PG8_WAIT_L(0); PG8_BAR; PG8_MMA(0, 0, At, B0); PG8_MMA(0, 1, At, B1); PG8_BAR; PG8_SCHED;
            PG8_LDA(At, 0, 1); PG8_STAGE(PG8_SB(0, 0), b2); PG8_STAGE(PG8_SB(0, 1), b2 + hstep); PG8_STAGE(PG8_SA(0, 0), a2);
            PG8_WAIT_V(8); PG8_WAIT_L(0); PG8_BAR; PG8_MMA(1, 0, At, B0); PG8_MMA(1, 1, At, B1); PG8_BAR; PG8_SCHED;
            PG8_LDB(B0, 1, 0); PG8_LDB(B1, 1, 1); PG8_SCHED; PG8_LDA(At, 1, 0); PG8_STAGE(PG8_SA(0, 1), a2 + hstep);
            PG8_WAIT_V(8); PG8_WAIT_L(0); PG8_BAR; PG8_MMA(0, 0, At, B0); PG8_MMA(0, 1, At, B1); PG8_BAR; PG8_SCHED;
            PG8_LDA(At, 1, 1); PG8_STAGE(PG8_SB(1, 0), b3); PG8_STAGE(PG8_SB(1, 1), b3 + hstep); PG8_STAGE(PG8_SA(1, 0), a3);
            PG8_WAIT_V(8); PG8_WAIT_L(0); PG8_BAR; PG8_MMA(1, 0, At, B0); PG8_MMA(1, 1, At, B1); PG8_BAR; PG8_SCHED;
        }
        if (wr == 0) PG8_BAR;
        E(acc, cur, wr, wc, fr, fq);
        if (!has_next) break;
#pragma unroll
        for (int a = 0; a < 2; ++a)
#pragma unroll
            for (int b = 0; b < 2; ++b)
#pragma unroll
                for (int m = 0; m < 4; ++m)
#pragma unroll
                    for (int n = 0; n < 2; ++n) acc[a][b][m][n] = (f32x4){0.f, 0.f, 0.f, 0.f};
        cur = nxt; cA = nA; cB = nB; ++ui;
        if (wr == 1) PG8_BAR;
    }
    PG8_WAIT_V(0);
    PG8_BAR;
#undef PG8_SA
#undef PG8_SB
#undef PG8_STAGE
#undef PG8_LDA
#undef PG8_LDB
#undef PG8_MMA
#undef PG8_WAIT_V
#undef PG8_WAIT_L
#undef PG8_BAR
#undef PG8_SCHED
}
}

__device__ __forceinline__ float row_rstd(const float* ssp, int row) {
    const f32x4 a = *(const f32x4*)(ssp + (size_t)row * 4);
    return __builtin_amdgcn_rsqf(((a[0] + a[1]) + (a[2] + a[3])) * (1.0f / D) + EPS);
}
__device__ __forceinline__ float rstd_of(const f32x4 a) { return __builtin_amdgcn_rsqf(((a[0] + a[1]) + (a[2] + a[3])) * (1.0f / D) + EPS); }
struct EpiSwiglu {
    ECtx c;
    __device__ __forceinline__ void operator()(const f32x4 (&acc)[2][2][4][2], const pg8::Unit& u, int wr, int wc, int fr, int fq) const {
        unsigned char* ws = c.kp->ws;
        bf16_t* act = (bf16_t*)(ws + WS_ACT); const float* ssp = (const float*)(ws + WS_SSP);
        const float* bias = (const float*)(ws + WS_BIAS) + (size_t)c.l * 9 * NB + (c.k == 5 ? 7936 : 0);
        const int kind = u.pm < 32 ? 0 : 1 + ((u.pm - 32) >> 2);
        const float* bp = bias + (size_t)kind * NB + u.pn * 256 + wc * 32 + fq * 4;
        f32x4 bg[2], bu[2];
#pragma unroll
        for (int bj = 0; bj < 2; ++bj) { bg[bj] = *(const f32x4*)(bp + bj * 128); bu[bj] = *(const f32x4*)(bp + bj * 128 + 16); }
        const float* sbase = ssp + (size_t)(u.pm * 256 + wr * 64 + fr) * 4;
        f32x4 sn = *(const f32x4*)sbase;
#pragma unroll
        for (int ai = 0; ai < 2; ++ai)
#pragma unroll
            for (int m = 0; m < 4; ++m) {
                int row = u.pm * 256 + ai * 128 + wr * 64 + m * 16 + fr; asm volatile("" : "+v"(row));
                const float rs = rstd_of(sn);
                if (ai * 4 + m < 7) sn = *(const f32x4*)(sbase + (((m + 1) >> 2) + ai) * 512 + ((m + 1) & 3) * 64);
                bf16_t* rp = act + (size_t)row * FF + u.pn * 128 + wc * 32 + fq * 8;
                u32x4 w;
                { const f32x4 gg = acc[ai][0][m][0] * rs + bg[0], uu = acc[ai][0][m][1] * rs + bu[0];
                  w.x = pk2(silu_f(gg[0]) * uu[0], silu_f(gg[1]) * uu[1]); w.y = pk2(silu_f(gg[2]) * uu[2], silu_f(gg[3]) * uu[3]); }
                { const f32x4 gg = acc[ai][1][m][0] * rs + bg[1], uu = acc[ai][1][m][1] * rs + bu[1];
                  w.z = pk2(silu_f(gg[0]) * uu[0], silu_f(gg[1]) * uu[1]); w.w = pk2(silu_f(gg[2]) * uu[2], silu_f(gg[3]) * uu[3]); }
                *(u32x4*)rp = w;
            }
    }
};
struct EpiRes {
    ECtx c;
    __device__ __forceinline__ void operator()(const f32x4 (&acc)[2][2][4][2], const pg8::Unit& u, int wr, int wc, int fr, int fq) const {
        unsigned char* ws = c.kp->ws; float* xout = c.kp->out;
        const float* MOD = (const float*)(ws + WS_MOD); const float* modl = MOD + (size_t)c.l * 81 * 1024;
        const bool from_in = c.l == 0 && c.k == 1;
        const float* xin_ctx = c.kp->x_prompt; const float* xin_lat = c.kp->x_sample;
        const int gi = c.k == 4 ? 5 : (c.k == 1 ? 2 : 8); const float coef = c.k == 4 ? 1.0f : 0.5f;
        const int nsub = c.k == 4 ? 2 : (c.k == 1 ? 1 : 0), nl = c.k == 6 ? c.l + 1 : c.l;
        const float* ng = nl < 2 ? c.kp->norm_g + (size_t)(nl * 3 + nsub) * 1024 : nullptr;
        const float* nmod = MOD + (size_t)nl * 81 * 1024; const int nsc = 3 * nsub + 1;
        bf16_t* hn = (bf16_t*)(ws + WS_H); float* ssp = (float*)(ws + WS_SSP);
        LAS float* ssl = (LAS float*)c.lds_epi_;
        const int kind = u.pm < 32 ? 0 : 1 + ((u.pm - 32) >> 2);
        const float* gv = modl + (size_t)(kind * 9 + gi) * 1024;
        const int col0 = u.pn * 256 + wc * 32 + fq * 8;
        f32x4 gt[2][2], gs[2][2];
#pragma unroll
        for (int bj = 0; bj < 2; ++bj)
#pragma unroll
            for (int n = 0; n < 2; ++n) {
                gt[bj][n] = *(const f32x4*)(gv + col0 + bj * 128 + n * 4) * coef;
                if (ng) gs[bj][n] = *(const f32x4*)(ng + col0 + bj * 128 + n * 4) * (*(const f32x4*)(nmod + (size_t)(kind * 9 + nsc) * 1024 + col0 + bj * 128 + n * 4) + 1.0f);
            }
        const float* xin = u.pm < 32 ? xin_ctx : xin_lat;
        const int rbase = (u.pm < 32 ? u.pm : u.pm - 32) * 256;
        bf16_t* xb = (bf16_t*)(ws + WS_XB);
        const bool is_last = nl >= 2;
        u32x4 xnb[2];
        if (!from_in) { const bf16_t* xp0 = xb + (size_t)(u.pm * 256 + wr * 64 + fr) * D + col0;
#pragma unroll
            for (int bj = 0; bj < 2; ++bj) xnb[bj] = *(const u32x4*)(xp0 + bj * 128); }
#pragma unroll
        for (int ai = 0; ai < 2; ++ai)
#pragma unroll
            for (int m = 0; m < 4; ++m) {
                int rl = ai * 128 + wr * 64 + m * 16 + fr; asm volatile("" : "+v"(rl));
                const float* ip = xin + (size_t)(rbase + rl) * D + col0;
                float* op = xout + (size_t)(u.pm * 256 + rl) * D + col0;
                bf16_t* hp = hn + (size_t)(u.pm * 256 + rl) * D + col0;
                bf16_t* xp = xb + (size_t)(u.pm * 256 + rl) * D + col0;
                f32x4 xc[2][2];
                if (from_in) {
#pragma unroll
                    for (int bj = 0; bj < 2; ++bj)
#pragma unroll
                        for (int n = 0; n < 2; ++n) xc[bj][n] = *(const f32x4*)(ip + bj * 128 + n * 4);
                } else {
#pragma unroll
                    for (int bj = 0; bj < 2; ++bj)
#pragma unroll
                        for (int n = 0; n < 2; ++n) { const unsigned wx_ = n ? xnb[bj].z : xnb[bj].x, wy_ = n ? xnb[bj].w : xnb[bj].y;
                            xc[bj][n] = (f32x4){__builtin_bit_cast(float, wx_ << 16), __builtin_bit_cast(float, wx_ & 0xffff0000u), __builtin_bit_cast(float, wy_ << 16), __builtin_bit_cast(float, wy_ & 0xffff0000u)}; }
                    if (ai * 4 + m < 7) { const bf16_t* xpn = xp + (size_t)((m == 3 ? 128 - 48 : 16)) * D;
#pragma unroll
                        for (int bj = 0; bj < 2; ++bj) xnb[bj] = *(const u32x4*)(xpn + bj * 128); }
                }
                float ss = 0.f;
#pragma unroll
                for (int bj = 0; bj < 2; ++bj) {
                    const f32x4 x0 = xc[bj][0] + gt[bj][0] * acc[ai][bj][m][0], x1 = xc[bj][1] + gt[bj][1] * acc[ai][bj][m][1];
                    if (is_last) { *(f32x4*)(op + bj * 128) = x0; *(f32x4*)(op + bj * 128 + 4) = x1; }
                    else { u32x4 wx; wx.x = pk2(x0[0], x0[1]); wx.y = pk2(x0[2], x0[3]); wx.z = pk2(x1[0], x1[1]); wx.w = pk2(x1[2], x1[3]); *(u32x4*)(xp + bj * 128) = wx; }
                    if (ng) {
                        ss += ((x0[0] * x0[0] + x0[1] * x0[1]) + (x0[2] * x0[2] + x0[3] * x0[3])) + ((x1[0] * x1[0] + x1[1] * x1[1]) + (x1[2] * x1[2] + x1[3] * x1[3]));
                        const f32x4 h0 = x0 * gs[bj][0], h1 = x1 * gs[bj][1];
                        u32x4 wh; wh.x = pk2(h0[0], h0[1]); wh.y = pk2(h0[2], h0[3]); wh.z = pk2(h1[0], h1[1]); wh.w = pk2(h1[2], h1[3]);
                        *(u32x4*)(hp + bj * 128) = wh;
                    }
                }
                if (ng) {
                    ss += __shfl_xor(ss, 16); ss += __shfl_xor(ss, 32);
                    if (fq == 0) ssl[rl * 4 + wc] = ss;
                }
            }
        if (ng) {
            asm volatile("s_waitcnt lgkmcnt(0)" ::: "memory"); __builtin_amdgcn_s_barrier(); asm volatile("" ::: "memory");
            const int t = wr * 256 + wc * 64 + fq * 16 + fr;
            if (t < 256) { const f32x4 a = *(const LAS f32x4*)(ssl + t * 4); ssp[(size_t)(u.pm * 256 + t) * 4 + u.pn] = (a[0] + a[1]) + (a[2] + a[3]); }
        }
    }
};
struct EpiBias {
    ECtx c;
    __device__ __forceinline__ void operator()(const f32x4 (&acc)[2][2][4][2], const pg8::Unit& u, int wr, int wc, int fr, int fq) const {
        float* bias = (float*)(c.kp->ws + WS_BIAS) + (size_t)c.l * 9 * NB;
        const int which = u.pn < 22 ? 0 : (u.pn < 31 ? 1 : 2);
        if (wr != 0) return;
#pragma unroll
        for (int m = 0; m < 2; ++m) {
            const int kind = m * 16 + fr - 9 * which;
            if (kind >= 0 && kind < 9) {
#pragma unroll
                for (int bj = 0; bj < 2; ++bj)
#pragma unroll
                    for (int n = 0; n < 2; ++n) *(f32x4*)(bias + (size_t)kind * NB + u.pn * 256 + bj * 128 + wc * 32 + n * 16 + fq * 4) = acc[0][bj][m][n];
            }
        }
    }
};
struct EpiIn {
    ECtx c;
    __device__ __forceinline__ void operator()(const f32x4 (&acc)[2][2][4][2], const pg8::Unit& u, int wr, int wc, int fr, int fq) const {
        unsigned char* ws = c.kp->ws; float* out = c.kp->out; const int layer = c.l;
        const float* qg = c.kp->q_norm_g + layer * 64; const float* kg = c.kp->k_norm_g + layer * 64; const float* vng = c.kp->sg_vnorm_g + layer * 256;
        const float* ssp = (const float*)(ws + WS_SSP); const float* bias = (const float*)(ws + WS_BIAS) + (size_t)layer * 9 * NB + 5632;
        const int pn = u.pn;
        const int kind = u.pm < 32 ? 0 : 1 + ((u.pm - 32) >> 2);
        const float* sbase = ssp + (size_t)(u.pm * 256 + wr * 64 + fr) * 4;
        f32x4 sn = *(const f32x4*)sbase;
        f32x4 bz[2][2];
#pragma unroll
        for (int bj = 0; bj < 2; ++bj)
#pragma unroll
            for (int n = 0; n < 2; ++n) bz[bj][n] = *(const f32x4*)(bias + (size_t)kind * NB + pn * 256 + bj * 128 + wc * 32 + n * 16 + fq * 4);
#pragma unroll
        for (int ai = 0; ai < 2; ++ai)
#pragma unroll
            for (int m = 0; m < 4; ++m) {
                int row = u.pm * 256 + ai * 128 + wr * 64 + m * 16 + fr; asm volatile("" : "+v"(row));
                const float rs = rstd_of(sn);
                if (ai * 4 + m < 7) sn = *(const f32x4*)(sbase + (((m + 1) >> 2) + ai) * 512 + ((m + 1) & 3) * 64);
                f32x4 v[2][2];
#pragma unroll
                for (int bj = 0; bj < 2; ++bj)
#pragma unroll
                    for (int n = 0; n < 2; ++n) v[bj][n] = acc[ai][bj][m][n] * rs + bz[bj][n];
#define PK8(dst16, x0, x1) do { u32x4 w_; w_.x = pk2((x0)[0], (x0)[1]); w_.y = pk2((x0)[2], (x0)[3]); w_.z = pk2((x1)[0], (x1)[1]); w_.w = pk2((x1)[2], (x1)[3]); *(u32x4*)(dst16) = w_; } while (0)
                if (pn == 0) {
                    bf16_t* za = (bf16_t*)(ws + WS_ZA) + (size_t)row * 256 + wc * 64 + fq * 8;
#pragma unroll
                    for (int bj = 0; bj < 2; ++bj) PK8(za + bj * 32, v[bj][0], v[bj][1]);
                } else if (pn <= 4) {
                    const bool isk = pn >= 3; const int h = (isk ? pn - 3 : pn - 1) * 4 + wc;
                    bf16_t* qb = (bf16_t*)(ws + WS_Q); bf16_t* kb = (bf16_t*)(ws + WS_K);
                    float ss = 0.f;
#pragma unroll
                    for (int bj = 0; bj < 2; ++bj)
#pragma unroll
                        for (int n = 0; n < 2; ++n) ss += (v[bj][n][0] * v[bj][n][0] + v[bj][n][1] * v[bj][n][1]) + (v[bj][n][2] * v[bj][n][2] + v[bj][n][3] * v[bj][n][3]);
                    ss += __shfl_xor(ss, 16); ss += __shfl_xor(ss, 32);
                    const float rstd = __builtin_amdgcn_rsqf(ss * (1.0f / 64.0f) + EPS);
                    const float* gn = isk ? kg : qg;
                    bf16_t* dst = isk ? kb + ((size_t)h * M + (row & ~31)) * 64 + (fq >> 1) * 512 + (row & 31) * 16 + (fq & 1) * 8 : qb + ((size_t)h * M + row) * 64 + fq * 8;
#pragma unroll
                    for (int bj = 0; bj < 2; ++bj) {
                        const int dd = bj * 32 + fq * 8;
                        const float qs = isk ? rstd : rstd * (0.125f * LOG2E);
                        const f32x4 o0 = v[bj][0] * qs * *(const f32x4*)(gn + dd), o1 = v[bj][1] * qs * *(const f32x4*)(gn + dd + 4);
                        PK8(dst + (isk ? bj * 1024 : bj * 32), o0, o1);
                        if (isk && row < MCTX) { float* nk = out + NK_OFF + ((((size_t)(row >> 8) * 2 + layer) * 8 + h) * 256 + (row & 255)) * 64 + dd; *(f32x4*)nk = o0; *(f32x4*)(nk + 4) = o1; }
                    }
                } else if (pn <= 6) {
                    const int h = (pn - 5) * 4 + wc;
                    bf16_t* vt = (bf16_t*)(ws + WS_VT);
                    bf16_t* vrow = vt + ((size_t)h * M + (row & ~31)) * 64 + ((row >> 3) & 1) * 512 + ((row >> 4) & 1) * 8 + (row & 7) + fq * 128;
#pragma unroll
                    for (int bj = 0; bj < 2; ++bj)
#pragma unroll
                        for (int n = 0; n < 2; ++n) {
#pragma unroll
                            for (int j = 0; j < 4; ++j) vrow[bj * 1024 + n * 64 + j * 16] = (bf16_t)f2bf(v[bj][n][j]);
                            if (row < MCTX) *(f32x4*)(out + NV_OFF + ((((size_t)(row >> 8) * 2 + layer) * 8 + h) * 256 + (row & 255)) * 64 + bj * 32 + fq * 8 + n * 4) = v[bj][n];
                        }
                } else if (pn == 7) {
                    bf16_t* ut = (bf16_t*)(ws + WS_UT) + (size_t)row * 256 + wc * 64 + fq * 8;
#pragma unroll
                    for (int bj = 0; bj < 2; ++bj) {
                        f32x4 g0, g1;
#pragma unroll
                        for (int j = 0; j < 4; ++j) { g0[j] = gelu_tanh(v[bj][0][j]); g1[j] = gelu_tanh(v[bj][1][j]); }
                        PK8(ut + bj * 32, g0, g1);
                    }
                } else {
                    float ss = 0.f;
#pragma unroll
                    for (int bj = 0; bj < 2; ++bj)
#pragma unroll
                        for (int n = 0; n < 2; ++n) {
#pragma unroll
                            for (int j = 0; j < 4; ++j) { v[bj][n][j] = gelu_tanh(v[bj][n][j]); ss += v[bj][n][j] * v[bj][n][j]; }
                        }
                    ss += __shfl_xor(ss, 16); ss += __shfl_xor(ss, 32);
                    const float rstd = __builtin_amdgcn_rsqf(ss * (1.0f / 64.0f) + EPS);
                    bf16_t* vgt = (bf16_t*)(ws + WS_VGT);
                    bf16_t* vgrow = vgt + (size_t)(row >> 7) * 32768 + ((row >> 4) & 7) * 512 + ((row >> 3) & 1) * 8 + (row & 7) + wc * 8192 + fq * 128;
#pragma unroll
                    for (int bj = 0; bj < 2; ++bj)
#pragma unroll
                        for (int n = 0; n < 2; ++n) {
                            const f32x4 o = v[bj][n] * rstd * *(const f32x4*)(vng + wc * 64 + bj * 32 + fq * 8 + n * 4);
#pragma unroll
                            for (int j = 0; j < 4; ++j) vgrow[bj * 4096 + n * 64 + j * 16] = (bf16_t)f2bf(o[j]);
                        }
                }
#undef PK8
            }
    }
};

struct EpiAll {
    ECtx c0;
    __device__ __forceinline__ void operator()(const f32x4 (&acc)[2][2][4][2], const pg8::Unit& u, int wr, int wc, int fr, int fq) const {
        ECtx c = c0; asm volatile("" : "+s"(c.kp));
        if (u.pm < 0) { ECtx cb = c; cb.l = 1; pg8::Unit ub; ub.pm = 0; ub.pn = u.pn - 48; EpiBias{cb}(acc, ub, wr, wc, fr, fq); }
        else if (c.k == 0 || c.k == 5) EpiSwiglu{c}(acc, u, wr, wc, fr, fq); else if (c.k == 2) EpiIn{c}(acc, u, wr, wc, fr, fq); else if (c.k < 0) EpiBias{c}(acc, u, wr, wc, fr, fq); else EpiRes{c}(acc, u, wr, wc, fr, fq);
    }
};
struct Frame {
    LAS unsigned char* lds;
    int tid, lane, wave, G, bid;
};

__device__ __forceinline__ void transpose_item(const float* src  , int sstride, int K, bf16_t* WT, int n0, int k0, LAS float* scr, int lane) {
    float tv[32];
#pragma unroll
    for (int i = 0; i < 32; ++i) tv[i] = __builtin_nontemporal_load(src + (size_t)(k0 + 2 * i + (lane >> 5)) * sstride);
#pragma unroll
    for (int i = 0; i < 32; ++i) scr[(2 * i + (lane >> 5)) * 33 + (lane & 31)] = tv[i];
    asm volatile("s_waitcnt lgkmcnt(0)" ::: "memory");
    const int c = lane & 7;
#pragma unroll
    for (int j = 0; j < 4; ++j) { const int n = (lane >> 3) + 8 * j; const LAS float* s = scr + (8 * c) * 33 + n;
        u32x4 o; o.x = pk2(s[0 * 33], s[1 * 33]); o.y = pk2(s[2 * 33], s[3 * 33]); o.z = pk2(s[4 * 33], s[5 * 33]); o.w = pk2(s[6 * 33], s[7 * 33]);
        *(u32x4*)(WT + (size_t)(n0 + n) * K + k0 + 8 * c) = o; }
    asm volatile("s_waitcnt lgkmcnt(0)" ::: "memory");
}

constexpr int CV_GU = 16 * 176, CV_D = 44 * 32, CV_IN = 16 * 72, CV_OUT = 16 * 32, CV_NA = 2 * CV_GU + CV_IN, CV_LAYER = CV_NA + 2 * CV_D + CV_OUT;
__device__ __forceinline__ void convert_items(const Params& p, Frame& F, int l, int lo, int hi, int widx, int nw) {
    LAS float* scr = (LAS float*)(F.lds + F.wave * 16896);
    unsigned char* wl = p.ws + WS_W + (size_t)l * W_LAYER;
    const int q = F.lane & 31;
    for (int it = lo + widx; it < hi; it += nw) {
        int r = it;
        if (r < 2 * CV_GU) {
            const int f = r / CV_GU; r %= CV_GU; const int kb = r / 176, nb = r % 176, n0 = nb * 32;
            const int tile = n0 >> 8, p0 = n0 & 255, ffcol = tile * 128 + 32 * ((p0 >> 5) & 3) + 8 * ((q & 15) >> 2) + 4 * (p0 >> 7) + (q & 3);
            const float* src = ((q >> 4) ? p.w_up : p.w_gate) + (size_t)(l * 2 + f) * D * FF + ffcol;
            transpose_item(src, FF, D, (bf16_t*)(wl + (f ? W_GU1 : W_GU0)), n0, kb * 64, scr, F.lane); continue; }
        r -= 2 * CV_GU;
        if (r < CV_IN) {
            const int kb = r / 72, nb = r % 72, n0 = nb * 32, p0 = n0 & 255;
            const int lcol = (n0 & ~255) + 64 * ((p0 >> 5) & 3) + 32 * (p0 >> 7) + 8 * ((q & 15) >> 2) + 4 * (q >> 4) + (q & 3);
            const float* src = p.w_in + (size_t)l * D * NIN + lcol;
            transpose_item(src, NIN, D, (bf16_t*)(wl + W_IN), n0, kb * 64, scr, F.lane); continue; }
        r -= CV_IN;
        if (r < 2 * CV_D) {
            const int f = r / CV_D; r %= CV_D; const int kb = r / 32, nb = r % 32, n0 = nb * 32;
            const float* src = p.w_down + (size_t)(l * 2 + f) * FF * D + n0 + (8 * ((q & 15) >> 2) + 4 * (q >> 4) + (q & 3));
            transpose_item(src, D, FF, (bf16_t*)(wl + W_D + f * W_D_SZ), n0, kb * 64, scr, F.lane); continue; }
        r -= 2 * CV_D;
        { const int kb = r / 32, nb = r % 32, n0 = nb * 32;
          const float* src = p.w_out + (size_t)l * D * D + n0 + (8 * ((q & 15) >> 2) + 4 * (q >> 4) + (q & 3));
          transpose_item(src, D, D, (bf16_t*)(wl + W_OUT), n0, kb * 64, scr, F.lane); }
    }
}

__device__ __forceinline__ void phase_prologue(const Params& p, Frame& F) {
    float* MOD = (float*)(p.ws + WS_MOD);
    for (int item = F.bid; item < 144; item += F.G) {
        const int l = item / 72, jc = item % 72;
        LAS float* sc = (LAS float*)F.lds; LAS float* red = sc + 9 * 1024;
        for (int i = F.tid; i < 9 * 1024; i += 512) { const int s = i >> 10, k = i & 1023; const float v = s == 0 ? p.c_ctx[k] : p.c[(s - 1) * 1024 + k]; sc[i] = silu_f(v); }
        __syncthreads();
        const float* w = p.ada_w + (size_t)l * 1024 * 9216 + (size_t)(F.wave * 128) * 9216 + jc * 128 + F.lane * 2;
        f32x2 acc[9];
#pragma unroll
        for (int s = 0; s < 9; ++s) acc[s] = (f32x2){0.f, 0.f};
        for (int k0 = 0; k0 < 128; k0 += 32) {
            f32x2 wv[32];
#pragma unroll
            for (int k = 0; k < 32; ++k) wv[k] = __builtin_nontemporal_load((const f32x2*)(w + (size_t)(k0 + k) * 9216));
#pragma unroll
            for (int k = 0; k < 32; ++k) {
#pragma unroll
                for (int s = 0; s < 9; ++s) acc[s] += sc[s * 1024 + F.wave * 128 + k0 + k] * wv[k];
            }
        }
#pragma unroll
        for (int s = 0; s < 9; ++s) { red[(F.wave * 9 + s) * 128 + F.lane * 2] = acc[s].x; red[(F.wave * 9 + s) * 128 + F.lane * 2 + 1] = acc[s].y; }
        __syncthreads();
        for (int i = F.tid; i < 9 * 128; i += 512) { const int s = i >> 7, j = i & 127; float sum = p.ada_b[l * 9216 + jc * 128 + j];
#pragma unroll
            for (int w8 = 0; w8 < 8; ++w8) sum += red[(w8 * 9 + s) * 128 + j];
            MOD[(size_t)(l * 9 + s) * 9216 + jc * 128 + j] = sum;
            const int mi = jc >> 3;
            if (mi % 3 == 0) ((bf16_t*)(p.ws + WS_SHB))[((size_t)l * 256 + 9 * (mi / 3) + s) * 1024 + (jc & 7) * 128 + j] = (bf16_t)f2bf(sum); }
        __syncthreads();
    }
    const int gw = F.bid * 8 + F.wave, NGW = F.G * 8;
    LAS float* scr = (LAS float*)(F.lds + F.wave * 16896);
    { unsigned* z = (unsigned*)(p.ws + WS_SHB);
      for (int i = gw * 64 + F.lane; i < 2 * 229 * 512; i += NGW * 64) { const int l = i / (229 * 512), r = i % (229 * 512); z[((size_t)l * 256 + 27) * 512 + r] = 0u; } }
    { bf16_t* SW = (bf16_t*)(p.ws + WS_SW);
      for (int i = gw * 64 + F.lane; i < 2 * 4 * 128 * 128 / 2; i += NGW * 64) { const f32x2 v = *(const f32x2*)(p.sg_w + 2 * (size_t)i); ((unsigned*)SW)[i] = pk2(v.x, v.y); } }
    { bf16_t* PW = (bf16_t*)(p.ws + WS_PW);
      for (int i = gw * 64 + F.lane; i < 2 * 4 * 64 * 64; i += NGW * 64) { const int c = i & 63, d = (i >> 6) & 63, lg = i >> 12; PW[i] = (bf16_t)f2bf(p.pool_w[((size_t)lg * 64 + c) * 64 + d]); } }
    { bf16_t* CK = (bf16_t*)(p.ws + WS_CK); bf16_t* CVT = (bf16_t*)(p.ws + WS_CVT);
      const bool split = F.G == 256;
      const int cw = split ? gw - 144 * 8 : gw, cnw = split ? (256 - 144) * 8 : NGW;
      if (cw >= 0)
      for (int it = cw; it < 128 * 4; it += cnw) {
          const int mat = it >> 2, t0 = (it & 3) * 64;
          const float* ks = p.cache_k + ((size_t)mat * 256 + t0) * 64; const float* vs = p.cache_v + ((size_t)mat * 256 + t0) * 64;
          const int d = F.lane;
          for (int tq = 0; tq < 64; tq += 16) {
              float kv[16], vv[16];
#pragma unroll
              for (int t = 0; t < 16; ++t) { kv[t] = __builtin_nontemporal_load(ks + (tq + t) * 64 + d); vv[t] = __builtin_nontemporal_load(vs + (tq + t) * 64 + d); }
#pragma unroll
              for (int t = 0; t < 16; ++t) {
                  const int tt = t0 + tq + t, key = tt & 31; const size_t tb = ((size_t)mat * 8 + (tt >> 5)) * 2048;
                  CK[tb + ((d >> 4) * 32 + key) * 16 + (d & 15)] = (bf16_t)f2bf(kv[t]);
                  CVT[tb + (((d >> 5) * 2 + ((key >> 3) & 1)) * 32 + (d & 31)) * 16 + (key >> 4) * 8 + (key & 7)] = (bf16_t)f2bf(vv[t]);
              }
          }
      } }
    convert_items(p, F, 0, 0, CV_NA, gw, NGW);
    if (F.G != 256) { convert_items(p, F, 0, CV_NA, CV_LAYER, gw, NGW); convert_items(p, F, 1, 0, CV_LAYER, gw, NGW); }
}

__device__ __forceinline__ void phase_norm0(const Params& p, Frame& F) {
    bf16_t* H = (bf16_t*)(p.ws + WS_H); float* SSP = (float*)(p.ws + WS_SSP);
    const float* modl = (const float*)(p.ws + WS_MOD);
    const bool split = F.G == 256;
    if (split && F.bid < 53) return;
    const int gw = (split ? F.bid - 53 : F.bid) * 8 + F.wave, NGW = (split ? F.G - 53 : F.G) * 8;
    for (int r0 = gw * 8; r0 < M; r0 += NGW * 8) {
        const int kind = kind_of_row(r0);
        const float* sc = modl + (size_t)(kind * 9 + 1) * 1024;
        f32x4 gs[4];
#pragma unroll
        for (int j = 0; j < 4; ++j) { const int col = 4 * F.lane + 256 * j; gs[j] = *(const f32x4*)(p.norm_g + col) * (*(const f32x4*)(sc + col) + 1.0f); }
#pragma unroll 4
        for (int rr = 0; rr < 8; ++rr) {
            const int row = r0 + rr;
            const float* xr = row < MCTX ? p.x_prompt + (size_t)row * D : p.x_sample + (size_t)(row - MCTX) * D;
            f32x4 v[4]; float s = 0.f;
#pragma unroll
            for (int j = 0; j < 4; ++j) { v[j] = *(const f32x4*)(xr + 4 * F.lane + 256 * j); s += (v[j][0] * v[j][0] + v[j][1] * v[j][1]) + (v[j][2] * v[j][2] + v[j][3] * v[j][3]); }
            s = wave_sum(s);
            if (F.lane < 4) SSP[(size_t)row * 4 + F.lane] = F.lane == 0 ? s : 0.f;
#pragma unroll
            for (int j = 0; j < 4; ++j) { const f32x4 o = v[j] * gs[j]; u32x2 w; w.x = pk2(o[0], o[1]); w.y = pk2(o[2], o[3]);
                *(u32x2*)(H + (size_t)row * D + 4 * F.lane + 256 * j) = w; }
        }
    }
}

__device__ __forceinline__ float half_max(float v) {
    const auto rr = __builtin_amdgcn_permlane32_swap(__builtin_bit_cast(unsigned, v), __builtin_bit_cast(unsigned, v), false, false);
    return fmaxf(__builtin_bit_cast(float, (unsigned)rr[0]), __builtin_bit_cast(float, (unsigned)rr[1]));
}
__device__ __forceinline__ float half_sum(float v) {
    const auto rr = __builtin_amdgcn_permlane32_swap(__builtin_bit_cast(unsigned, v), __builtin_bit_cast(unsigned, v), false, false);
    return __builtin_bit_cast(float, (unsigned)rr[0]) + __builtin_bit_cast(float, (unsigned)rr[1]);
}
struct AttnState { f32x16 O0, O1; float m, l; };
struct KF { bf16x8 k[4]; };
struct VF { bf16x8 v[2][2]; };
__device__ __forceinline__ void load_k(KF& f, const bf16_t* Kp, int lane) {
    const int rho = lane & 31, key = 16 * ((rho >> 2) & 1) + 4 * (rho >> 3) + (rho & 3);
    const bf16_t* kp = Kp + key * 16 + (lane >> 5) * 8;
#pragma unroll
    for (int c = 0; c < 4; ++c) f.k[c] = *(const bf16x8*)(kp + 512 * c);
}
__device__ __forceinline__ void load_v(VF& f, const bf16_t* Vp, int lane) {
    const bf16_t* vp = Vp + (lane & 31) * 16 + (lane >> 5) * 8;
#pragma unroll
    for (int mb = 0; mb < 2; ++mb)
#pragma unroll
        for (int c = 0; c < 2; ++c) f.v[mb][c] = *(const bf16x8*)(vp + (mb * 2 + c) * 512);
}
template <bool LOCAL>
__device__ __forceinline__ f32x16 qk_part(const bf16x8 (&qf)[4], const KF& f, int lane, const LAS float* bl, int th, int qc, int cs) {
    const int g = lane >> 5;
    f32x16 S;
#pragma unroll
    for (int i = 0; i < 16; ++i) S[i] = 0.f;
#pragma unroll
    for (int c = 0; c < 4; ++c) S = __builtin_amdgcn_mfma_f32_32x32x16_bf16(f.k[c], qf[c], S, 0, 0, 0);
    if (LOCAL) {
        const LAS float* bp = bl + (63 + th * 32 + 16 * g - qc);
        const int rel0 = th * 32 + 16 * g - cs;
        float bv[16];
#pragma unroll
        for (int i = 0; i < 16; ++i) bv[i] = bp[i];
#pragma unroll
        for (int i = 0; i < 16; ++i) {
            const float pen = (unsigned)(rel0 + i) < 16u ? 0.f : -1e30f;
            S[i] = (S[i] + bv[i]) + pen;
        }
    }
    return S;
}
__device__ __forceinline__ void pv_part(AttnState& st, f32x16 S, const VF& f) {
    float mt = S[0];
#pragma unroll
    for (int i = 1; i < 16; ++i) mt = fmaxf(mt, S[i]);
    mt = half_max(mt);
    if (__any(mt - st.m > 8.0f)) {
        const float mn = fmaxf(st.m, mt);
        const float alpha = __builtin_amdgcn_exp2f(st.m - mn);
        st.m = mn; st.l *= alpha;
#pragma unroll
        for (int i = 0; i < 16; ++i) { st.O0[i] *= alpha; st.O1[i] *= alpha; }
    }
    float ps = 0.f;
#pragma unroll
    for (int i = 0; i < 16; ++i) { S[i] = __builtin_amdgcn_exp2f(S[i] - st.m); ps += S[i]; }
    st.l += ps;
    bf16x8 pf[2];
#pragma unroll
    for (int c = 0; c < 2; ++c) {
        u32x4 w; w.x = pk2(S[8 * c + 0], S[8 * c + 1]); w.y = pk2(S[8 * c + 2], S[8 * c + 3]); w.z = pk2(S[8 * c + 4], S[8 * c + 5]); w.w = pk2(S[8 * c + 6], S[8 * c + 7]);
        pf[c] = __builtin_bit_cast(bf16x8, w);
    }
#define VFR(mb, c) (f.v[mb][c])
    st.O0 = __builtin_amdgcn_mfma_f32_32x32x16_bf16(VFR(0, 0), pf[0], st.O0, 0, 0, 0);
    st.O0 = __builtin_amdgcn_mfma_f32_32x32x16_bf16(VFR(0, 1), pf[1], st.O0, 0, 0, 0);
    st.O1 = __builtin_amdgcn_mfma_f32_32x32x16_bf16(VFR(1, 0), pf[0], st.O1, 0, 0, 0);
    st.O1 = __builtin_amdgcn_mfma_f32_32x32x16_bf16(VFR(1, 1), pf[1], st.O1, 0, 0, 0);
#undef VFR
}
template <bool LOCAL>
__device__ __forceinline__ void attn_run(AttnState& st, const bf16x8 (&qf)[4], const bf16_t* K0, const bf16_t* V0, int ntiles, int lane,
                                         const LAS float* rpbL, int r, int start, int qc, int cs) {
    KF ka, kb; VF va, vb;
    load_k(ka, K0, lane); load_v(va, V0, lane);
    for (int t = 0; t < ntiles; t += 2) {
        const LAS float* bl = rpbL + (start + (t >> 1) - r + 7) * 128;
        load_k(kb, K0 + (size_t)(t + 1) * 2048, lane);
        f32x16 S = qk_part<LOCAL>(qf, ka, lane, bl, 0, qc, cs);
        load_v(vb, V0 + (size_t)(t + 1) * 2048, lane);
        pv_part(st, S, va);
        const int tn = t + 2 < ntiles ? t + 2 : 0;
        load_k(ka, K0 + (size_t)tn * 2048, lane);
        S = qk_part<LOCAL>(qf, kb, lane, bl, 1, qc, cs);
        load_v(va, V0 + (size_t)tn * 2048, lane);
        pv_part(st, S, vb);
    }
}
__device__ __forceinline__ void attn_finish(Frame& F, AttnState& st, int q0, int h, const float* gb  , bf16_t* OB) {
    const int g = F.lane >> 5, ql = F.lane & 31;
    const float lt = half_sum(st.l);
    const float inv = 1.0f / lt;
    float ss = 0.f;
#pragma unroll
    for (int i = 0; i < 16; ++i) { st.O0[i] *= inv; st.O1[i] *= inv; ss += st.O0[i] * st.O0[i] + st.O1[i] * st.O1[i]; }
    ss = half_sum(ss);
    LAS float* hs = (LAS float*)(F.lds + 61440);
    if (g == 0) hs[h * 32 + ql] = ss;
    __syncthreads();
    float tot = 0.f;
#pragma unroll
    for (int hh = 0; hh < 8; ++hh) tot += hs[hh * 32 + ql];
    const float rstd = __builtin_amdgcn_rsqf(tot * (1.0f / 512.0f) + EPS);
    bf16_t* orow = OB + (size_t)(q0 + ql) * D + 256 + h * 64;
#pragma unroll
    for (int mb = 0; mb < 2; ++mb)
#pragma unroll
        for (int i = 0; i < 4; ++i) {
            const int d = 32 * mb + 8 * i + 4 * g;
            const f32x4 gv = *(const f32x4*)(gb + h * 64 + d);
            float o[4];
#pragma unroll
            for (int j = 0; j < 4; ++j) o[j] = (mb == 0 ? st.O0[4 * i + j] : st.O1[4 * i + j]) * rstd * gv[j];
            u32x2 w; w.x = pk2(o[0], o[1]); w.y = pk2(o[2], o[3]);
            *(u32x2*)(orow + d) = w;
        }
    __syncthreads();
}

__device__ __forceinline__ void pool_unit(const Params& p, Frame& F, int l, int u, const bf16_t* ZA, const bf16_t* PWT, bf16_t* OB, const float* ong) {
    const int lane = F.lane, g2 = lane >> 5, ql = lane & 31, w = F.wave;
    const int row0 = u * 32;
    const int seq0 = row0 < MCTX ? (row0 & ~255) : MCTX + ((row0 - MCTX) & ~1023);
    const int L = row0 < MCTX ? 256 : 1024, tloc = row0 - seq0;
    LAS float* A = (LAS float*)F.lds;
    LAS float* P = A + 48 * 256;
    LAS float* part = P + 32 * 260;
    bf16x8 af[4];
    { const bf16_t* ap = PWT + ((size_t)(l * 4 + (w >> 1)) * 64 + 32 * (w & 1) + ql) * 64 + 8 * g2;
#pragma unroll
      for (int kc = 0; kc < 4; ++kc) af[kc] = *(const bf16x8*)(ap + 16 * kc); }
    {
        unsigned wd[12];
#pragma unroll
        for (int it = 0; it < 12; ++it) { const int i = F.tid + it * 512, rr = i >> 7, cp = i & 127, tl = tloc - 8 + rr;
            wd[it] = 0u; if (tl >= 0 && tl < L) wd[it] = *(const unsigned*)(ZA + (size_t)(seq0 + tl) * 256 + 2 * cp); }
#pragma unroll
        for (int it = 0; it < 12; ++it) { const int i = F.tid + it * 512, rr = i >> 7, cp = i & 127;
            A[rr * 256 + 2 * cp] = __builtin_bit_cast(float, wd[it] << 16); A[rr * 256 + 2 * cp + 1] = __builtin_bit_cast(float, wd[it] & 0xffff0000u); }
    }
    __syncthreads();
    {
        const int ch = F.tid & 255, thh = F.tid >> 8, gi = ch >> 6;
        float a[31];
#pragma unroll
        for (int i = 0; i < 31; ++i) a[i] = A[(16 * thh + i) * 256 + ch];
#define POOL_WIN(HALF) do { _Pragma("unroll") for (int t = 0; t < 16; ++t) { float sm = 0.f; _Pragma("unroll") for (int j = -HALF; j < HALF; ++j) sm += a[8 + t + j]; \
            const int tl = tloc + 16 * thh + t; const int lo = max(tl - HALF, 0), hi = min(tl + HALF, L); \
            P[(16 * thh + t) * 260 + ch] = sm * __builtin_amdgcn_rcpf((float)(hi - lo)) - a[8 + t]; } } while (0)
        if (gi == 0) POOL_WIN(1); else if (gi == 1) POOL_WIN(2); else if (gi == 2) POOL_WIN(4); else POOL_WIN(8);
#undef POOL_WIN
    }
    __syncthreads();
    f32x16 Dm;
#pragma unroll
    for (int i = 0; i < 16; ++i) Dm[i] = 0.f;
    { const LAS float* pp = P + ql * 260 + (w >> 1) * 64 + 8 * g2;
#pragma unroll
      for (int kc = 0; kc < 4; ++kc) {
          const f32x4 x0 = *(const LAS f32x4*)(pp + 16 * kc), x1 = *(const LAS f32x4*)(pp + 16 * kc + 4);
          u32x4 wd; wd.x = pk2(x0[0], x0[1]); wd.y = pk2(x0[2], x0[3]); wd.z = pk2(x1[0], x1[1]); wd.w = pk2(x1[2], x1[3]);
          Dm = __builtin_amdgcn_mfma_f32_32x32x16_bf16(af[kc], __builtin_bit_cast(bf16x8, wd), Dm, 0, 0, 0);
      } }
    float ss = 0.f;
#pragma unroll
    for (int i = 0; i < 4; ++i) { const f32x4 ps = *(const f32x4*)(p.pool_scale + l * 256 + 32 * w + 8 * i + 4 * g2);
#pragma unroll
        for (int j = 0; j < 4; ++j) { Dm[4 * i + j] *= ps[j]; ss += Dm[4 * i + j] * Dm[4 * i + j]; } }
    ss = half_sum(ss);
    if (g2 == 0) part[w * 32 + ql] = ss;
    __syncthreads();
    float tot = 0.f;
#pragma unroll
    for (int w8 = 0; w8 < 8; ++w8) tot += part[w8 * 32 + ql];
    const float rstd = __builtin_amdgcn_rsqf(tot * (1.0f / 256.0f) + EPS);
#pragma unroll
    for (int i = 0; i < 4; ++i) { const int oc = 32 * w + 8 * i + 4 * g2; const f32x4 gv = *(const f32x4*)(ong + oc);
        u32x2 wv; wv.x = pk2(Dm[4 * i] * rstd * gv[0], Dm[4 * i + 1] * rstd * gv[1]); wv.y = pk2(Dm[4 * i + 2] * rstd * gv[2], Dm[4 * i + 3] * rstd * gv[3]);
        *(u32x2*)(OB + (size_t)(row0 + ql) * D + oc) = wv; }
    __syncthreads();
}

__device__ __forceinline__ void chunk_unit(const Params& p, Frame& F, int l, int u, const bf16_t* UB, const bf16_t* VGT, const bf16_t* SW, bf16_t* OB, const float* ong) {
    const int lane = F.lane, g = lane >> 5, ql = lane & 31;
    const int row0 = u * 128, w = F.wave, tb = w & 3, chh = w >> 2;
    const int tok = row0 + 32 * tb + ql;
    LAS float* part = (LAS float*)F.lds;
    float outv[2][2][16]; float ss = 0.f;
#pragma unroll
    for (int gs = 0; gs < 2; ++gs) {
        const int gi = 2 * chh + gs;
        bf16x8 bw[8];
        const bf16_t* wp = SW + ((size_t)(l * 4 + gi) * 128 + 32 * tb + ql) * 128 + 8 * g;
#pragma unroll
        for (int kc = 0; kc < 8; ++kc) bw[kc] = *(const bf16x8*)(wp + 16 * kc);
        const float bsv = p.sg_b[(size_t)(l * 4 + gi) * 128 + 32 * tb + ql];
#pragma unroll
        for (int cb = 0; cb < 2; ++cb) {
            const int ch0 = 64 * gi + 32 * cb;
            const bf16_t* ap = VGT + ((size_t)(u * 8 + 2 * gi + cb) * 8) * 512 + ql * 16 + 8 * g;
            s16x4 uv[4];
#pragma unroll
            for (int i = 0; i < 4; ++i) uv[i] = *(const s16x4*)(UB + (size_t)tok * 256 + ch0 + 8 * i + 4 * g);
            f32x16 Dm;
#pragma unroll
            for (int i = 0; i < 16; ++i) Dm[i] = 0.f;
#pragma unroll
            for (int kc = 0; kc < 8; ++kc) { const bf16x8 af = *(const bf16x8*)(ap + 512 * kc); Dm = __builtin_amdgcn_mfma_f32_32x32x16_bf16(af, bw[kc], Dm, 0, 0, 0); }
#pragma unroll
            for (int i = 0; i < 4; ++i)
#pragma unroll
                for (int j = 0; j < 4; ++j) { const float o = bf2f((unsigned short)uv[i][j]) * (Dm[4 * i + j] + bsv); outv[gs][cb][4 * i + j] = o; ss += o * o; }
        }
    }
    ss = half_sum(ss);
    if (g == 0) part[chh * 128 + 32 * tb + ql] = ss;
    __syncthreads();
    const float tot = part[32 * tb + ql] + part[128 + 32 * tb + ql];
    const float rstd = __builtin_amdgcn_rsqf(tot * (1.0f / 256.0f) + EPS);
#pragma unroll
    for (int gs = 0; gs < 2; ++gs)
#pragma unroll
        for (int cb = 0; cb < 2; ++cb)
#pragma unroll
            for (int i = 0; i < 4; ++i) {
                const int ch = 64 * (2 * chh + gs) + 32 * cb + 8 * i + 4 * g;
                const f32x4 gv = *(const f32x4*)(ong + 768 + ch);
                u32x2 wv; wv.x = pk2(outv[gs][cb][4 * i] * rstd * gv[0], outv[gs][cb][4 * i + 1] * rstd * gv[1]); wv.y = pk2(outv[gs][cb][4 * i + 2] * rstd * gv[2], outv[gs][cb][4 * i + 3] * rstd * gv[3]);
                *(u32x2*)(OB + (size_t)tok * D + 768 + ch) = wv;
            }
    __syncthreads();
}

__device__ __forceinline__ void phase_mix(const Params& p, Frame& F, int l) {
    const int lane = F.lane, h = F.wave, g = lane >> 5, ql = lane & 31;
    const int vb = (F.G % 8 == 0) ? (F.bid % 8) * (F.G / 8) + F.bid / 8 : F.bid;
    {
    const bf16_t* QB = (const bf16_t*)(p.ws + WS_Q); const bf16_t* KB = (const bf16_t*)(p.ws + WS_K); const bf16_t* VT = (const bf16_t*)(p.ws + WS_VT);
    const bf16_t* CK = (const bf16_t*)(p.ws + WS_CK); const bf16_t* CVT = (const bf16_t*)(p.ws + WS_CVT);
    bf16_t* OB = (bf16_t*)(p.ws + WS_OB);
    const float* ong = p.out_norm_g + l * 1024;
    for (int u = vb; u < 256; u += F.G) {
        const int b = u >> 5, r = (u >> 1) & 15, qh = u & 1;
        const int q0 = MCTX + b * 1024 + r * 64 + qh * 32;
        LAS float* rpbL = (LAS float*)(F.lds + F.wave * 7680);
        for (int i = lane; i < 15 * 128; i += 64) rpbL[i] = 0.f;
        { float tv[8];
#pragma unroll
          for (int k = 0; k < 8; ++k) { const int i = lane + 64 * k; tv[k] = i < 465 ? p.na_rpb[((size_t)l * 8 + h) * 465 + i] : 0.f; }
#pragma unroll
          for (int k = 0; k < 8; ++k) { const int i = lane + 64 * k; if (i < 465) rpbL[(i / 31) * 128 + 48 + (i % 31)] = tv[k] * LOG2E; } }
        bf16x8 qf[4];
#pragma unroll
        for (int c = 0; c < 4; ++c) qf[c] = *(const bf16x8*)(QB + ((size_t)h * M + q0 + ql) * 64 + 16 * c + 8 * g);
        AttnState st;
#pragma unroll
        for (int i = 0; i < 16; ++i) { st.O0[i] = 0.f; st.O1[i] = 0.f; }
        st.m = -1e30f; st.l = 0.f;
        const bf16_t* ck = CK + (size_t)((b * 2 + l) * 8 + h) * 256 * 64; const bf16_t* cvt = CVT + (size_t)((b * 2 + l) * 8 + h) * 64 * 256;
        attn_run<false>(st, qf, ck, cvt, 8, lane, rpbL, 0, 0, 0, 0);
        const int start = min(max(r - 4, 0), 8);
        const int qc = qh * 32 + ql, cs = min(max(qc - 8, 0), 48);
        const size_t toff = ((size_t)h * M + MCTX + b * 1024 + start * 64) * 64;
        attn_run<true>(st, qf, KB + toff, VT + toff, 16, lane, rpbL, r, start, qc, cs);
        attn_finish(F, st, q0, h, ong + 256, OB);
    }
    for (int u = vb; u < 256; u += F.G) {
        const int b = u >> 3, qb = u & 7, q0 = b * 256 + qb * 32;
        bf16x8 qf[4];
#pragma unroll
        for (int c = 0; c < 4; ++c) qf[c] = *(const bf16x8*)(QB + ((size_t)h * M + q0 + ql) * 64 + 16 * c + 8 * g);
        AttnState st;
#pragma unroll
        for (int i = 0; i < 16; ++i) { st.O0[i] = 0.f; st.O1[i] = 0.f; }
        st.m = -1e30f; st.l = 0.f;
        const size_t toff = ((size_t)h * M + b * 256) * 64;
        attn_run<false>(st, qf, KB + toff, VT + toff, 8, lane, (const LAS float*)F.lds, 0, 0, 0, 0);
        attn_finish(F, st, q0, h, ong + 256, OB);
    }
    }
    const bf16_t* ZA = (const bf16_t*)(p.ws + WS_ZA); const bf16_t* UB = (const bf16_t*)(p.ws + WS_UT); const bf16_t* VGT = (const bf16_t*)(p.ws + WS_VGT);
    const bf16_t* SW = (const bf16_t*)(p.ws + WS_SW); const bf16_t* PWT = (const bf16_t*)(p.ws + WS_PW);
    bf16_t* OB = (bf16_t*)(p.ws + WS_OB);
    const float* ong = p.out_norm_g + l * 1024;
    if (F.G == 256) {
        if (F.bid < 128) { chunk_unit(p, F, l, F.bid, UB, VGT, SW, OB, ong); pool_unit(p, F, l, F.bid, ZA, PWT, OB, ong); }
        else { for (int i = 0; i < 3; ++i) pool_unit(p, F, l, 128 + (F.bid - 128) * 3 + i, ZA, PWT, OB, ong); }
    } else {
        for (int u = F.bid; u < 128; u += F.G) chunk_unit(p, F, l, u, UB, VGT, SW, OB, ong);
        for (int u = F.bid; u < 512; u += F.G) pool_unit(p, F, l, u, ZA, PWT, OB, ong);
    }
}

#define XB_TMO      128
#define XB_XCNT(j)  (256  + 64 * (j))
#define XB_XSUB(j)  (1280 + 64 * (j))
#define XB_XGEN(j)  (2304 + 64 * (j))
#define XB_TOP      3328
#define XB_TOPGEN   3392
#define XCD_BAR_WORDS 3456
#define XB_SPIN_CAP (1u << 18)
__device__ __forceinline__ unsigned xb_ld(unsigned* p)              { return __hip_atomic_load(p, __ATOMIC_RELAXED, __HIP_MEMORY_SCOPE_AGENT); }
__device__ __forceinline__ unsigned xb_add(unsigned* p, unsigned v) { return __hip_atomic_fetch_add(p, v, __ATOMIC_RELAXED, __HIP_MEMORY_SCOPE_AGENT); }
__device__ __forceinline__ unsigned xb_xcc_id() { return (unsigned)__builtin_amdgcn_s_getreg((3 << 11) | 20) & 0xFu; }
#define XB_SPIN(cond, bar) do { unsigned _sp = 0; while (cond) { __builtin_amdgcn_s_sleep(1); \
    if ((++_sp & 255u) == 0u) { if (xb_ld(&(bar)[XB_TMO])) break; if (_sp > XB_SPIN_CAP) { atomicAdd(&(bar)[XB_TMO], 1u); break; } } } } while (0)
struct XcdBarrier { unsigned* bar; unsigned x; volatile LAS unsigned* st; };
__device__ __forceinline__ XcdBarrier xcd_barrier_post(unsigned* bar, volatile LAS unsigned* st) {
    XcdBarrier b; b.bar = bar; b.x = xb_xcc_id(); b.st = st;
    if (threadIdx.x == 0) (void)xb_add(&bar[XB_XCNT(b.x)], 1u);
    return b;
}
__device__ __forceinline__ void xcd_barrier_complete(unsigned* bar, unsigned x, unsigned& nloc, unsigned& nx) {
    const unsigned G = gridDim.x * gridDim.y * gridDim.z;
    unsigned sum, cnt, mine, sp = 0u;
    for (;;) {
        sum = 0u; cnt = 0u; mine = 0u;
#pragma unroll
        for (unsigned j = 0; j < 16; ++j) { const unsigned c = xb_ld(&bar[XB_XCNT(j)]); sum += c; cnt += (c > 0u) ? 1u : 0u; mine = (j == x) ? c : mine; }
        if (sum == G) break;
        __builtin_amdgcn_s_sleep(1);
        if ((++sp & 255u) == 0u) { if (xb_ld(&bar[XB_TMO])) break; if (sp > XB_SPIN_CAP) { atomicAdd(&bar[XB_TMO], 1u); break; } }
    }
    nloc = mine > 0u ? mine : 1u; nx = cnt > 0u ? cnt : 1u;
}
__device__ __forceinline__ void xcd_barrier(const XcdBarrier& b) {
    asm volatile("s_waitcnt vmcnt(0)" ::: "memory");
    __syncthreads();
    if (threadIdx.x == 0) {
        unsigned* bar = b.bar;
        __builtin_amdgcn_s_waitcnt(0);
        unsigned nloc = b.st[0], nx = b.st[1];
        if (nloc == 0u) { xcd_barrier_complete(bar, b.x, nloc, nx); b.st[0] = nloc; b.st[1] = nx; }
        const unsigned old = xb_add(&bar[XB_XSUB(b.x)], 1u);
        const unsigned gen = old / nloc;
        if (old + 1u == (gen + 1u) * nloc) {
            __builtin_amdgcn_fence(__ATOMIC_RELEASE, "agent");
            asm volatile("s_waitcnt vmcnt(0)" ::: "memory");
            const unsigned og = xb_add(&bar[XB_TOP], 1u);
            const unsigned tg = og / nx;
            if (og + 1u == (tg + 1u) * nx) xb_add(&bar[XB_TOPGEN], 1u);
            else XB_SPIN(xb_ld(&bar[XB_TOPGEN]) == tg, bar);
            __builtin_amdgcn_fence(__ATOMIC_ACQUIRE, "agent");
            xb_add(&bar[XB_XGEN(b.x)], 1u);
            asm volatile("s_waitcnt vmcnt(0)" ::: "memory");
        } else {
            XB_SPIN(xb_ld(&bar[XB_XGEN(b.x)]) == gen, bar);
            __builtin_amdgcn_fence(__ATOMIC_ACQUIRE, "agent");
            asm volatile("s_waitcnt vmcnt(0)" ::: "memory");
        }
    }
    __syncthreads();
}

constexpr int LDS_MISC = 135168;
constexpr int LDS_BYTES = LDS_MISC + 64;
constexpr int NPHASE = 16;

__global__ void __launch_bounds__(512, 2) fwd_megakernel(Params p_in) {
    extern __shared__ __attribute__((aligned(16))) unsigned char lds_raw[];
    cg::grid_group grid = cg::this_grid();
    { volatile LAS unsigned* st0 = (volatile LAS unsigned*)((LAS unsigned char*)lds_raw + LDS_MISC); if (threadIdx.x < 16) st0[threadIdx.x] = 0u; }
    __syncthreads();
    (void)xcd_barrier_post((unsigned*)(p_in.ws + WS_CTL), (volatile LAS unsigned*)((LAS unsigned char*)lds_raw + LDS_MISC));
#define XBAR() do { XcdBarrier xb_; xb_.bar = (unsigned*)(p_in.ws + WS_CTL); xb_.x = xb_xcc_id(); xb_.st = (volatile LAS unsigned*)((LAS unsigned char*)lds_raw + LDS_MISC); xcd_barrier(xb_); } while (0)
    if (p_in.ph_lo < 0) grid.sync();
    int rep_ = 0;
    int wave_s = __builtin_amdgcn_readfirstlane((int)threadIdx.x >> 6);
    KargPtr kp4 = (KargPtr)__builtin_amdgcn_kernarg_segment_ptr();
    const int ph_hi_ = p_in.ph_hi;
#pragma nounroll
    for (int ph = p_in.ph_lo; ph < ph_hi_; ++ph) {
        asm volatile("" : "+s"(wave_s));
        int lane_ = (int)__builtin_amdgcn_mbcnt_hi(~0u, __builtin_amdgcn_mbcnt_lo(~0u, 0u)); asm volatile("" : "+v"(lane_));
        int tid_ = wave_s * 64 + lane_;
        asm volatile("" : "+s"(kp4));
#if defined(__HIP_DEVICE_COMPILE__)
        const Params p = *kp4;
#else
        const Params p = p_in;
#endif
        int bid_ = blockIdx.x; asm volatile("" : "+s"(bid_));
        unsigned lds0 = 0; asm volatile("" : "+s"(lds0));
        Frame F;
        F.lds = (LAS unsigned char*)lds_raw + lds0;
        F.tid = tid_; F.lane = F.tid & 63; F.wave = __builtin_amdgcn_readfirstlane(F.tid >> 6);
        F.G = gridDim.x; F.bid = bid_;
        const float* MOD = (const float*)(p.ws + WS_MOD);
        bf16_t* H = (bf16_t*)(p.ws + WS_H); bf16_t* ACT = (bf16_t*)(p.ws + WS_ACT); bf16_t* OB = (bf16_t*)(p.ws + WS_OB);
        float* X = p.out;
        if (ph == 0) {
#if !defined(MASK) || ((MASK>>0)&1)
            phase_prologue(p, F);
#endif
        } else {
            const int l = ph == 1 ? 0 : (ph - 2) / 7, k = ph == 1 ? -1 : (ph - 2) % 7;
            const float* modl = MOD + (size_t)l * 81 * 1024;
            unsigned char* wl = p.ws + WS_W + (size_t)l * W_LAYER;
            if (k == 3) {
#if !defined(MASK) || ((MASK>>5)&1)
                phase_mix(p, F, l);
#endif
            } else {
#if !defined(MASK) || ((MASK>>2)&1)
                EpiAll E; E.c0 = ECtx{kp4, l, k, F.lds + 131072};
                pg8::Gemm g; int N;
                if (k == -1) { g = pg8::Gemm{(const bf16_t*)(p.ws + WS_SHB), (const bf16_t*)(p.ws + WS_W), 256, NB, D}; N = NB; }
                else if (k == 0 || k == 5) { g = pg8::Gemm{H, (const bf16_t*)(wl + (k == 0 ? W_GU0 : W_GU1)), M, NGU, D}; N = NGU; }
                else if (k == 4) { g = pg8::Gemm{OB, (const bf16_t*)(wl + W_OUT), M, D, D}; N = D; }
                else if (k == 2) { g = pg8::Gemm{H, (const bf16_t*)(wl + W_IN), M, NIN, D}; N = NIN; }
                else { const int f = k == 1 ? 0 : 1; g = pg8::Gemm{ACT, (const bf16_t*)(wl + W_D + f * W_D_SZ), M, D, FF}; N = D; }
                pg8::StaticOrder S;
                const bool full = F.G == 256;
                if (k == -1) {
                    const int lb = F.bid < 53 ? 0 : 1;
                    g.A = (const bf16_t*)(p.ws + WS_SHB) + (size_t)lb * 256 * 1024; g.Bt = (const bf16_t*)(p.ws + WS_W + (size_t)lb * W_LAYER); E.c0.l = lb;
                    S.init(256, NB, 53, F.bid % 53);
                    if (F.bid >= (full ? 53 : 106)) S.nwg = 0;
                } else {
                    S.init(M, N, F.G, F.bid);
                    if (full && l == 0 && k == 5 && F.bid >= 203) { S.exi = 5; S.expm = -167; S.expn = 48 + (F.bid - 203); }
                }
                pg8::gemm_phase<EpiAll>(F.lds, F.tid, g, S, E);
                if (k == -1) phase_norm0(p, F);
                if (full && l == 0) {
                    if (k == 0 && F.bid >= 128) convert_items(p, F, 0, CV_NA, CV_LAYER, (F.bid - 128) * 8 + F.wave, 128 * 8);
                    if (k == 2 && F.bid >= 64) convert_items(p, F, 1, 0, CV_NA, (F.bid - 64) * 8 + F.wave, 192 * 8);
                    if (k == 5 && F.bid >= 128 && F.bid < 203) convert_items(p, F, 1, CV_NA, CV_LAYER, (F.bid - 128) * 8 + F.wave, 75 * 8);
                }
#endif
            }
        }
#if PROBE_REP
        { const int kind_ = ph < 2 ? ph : 2 + (ph - 2) % 7;
          if (((PROBE_REP >> kind_) & 1) && rep_ == 0) { rep_ = 1; XBAR(); --ph; continue; }
          rep_ = 0; }
#endif
        if (ph + 1 < ph_hi_) XBAR();
    }
    for (int i_ = 0; i_ < PROBE_SYNC; ++i_) XBAR();
}

extern "C" void kernel_launch(void* const* d_in, const int* in_sizes, int n_in, void* d_out, int out_size, void* d_ws, size_t ws_size, hipStream_t stream) {
    static int grid_blocks = 0;
    if (!grid_blocks) {
        int dev = 0, cus = 0, per_cu = 0;
        hipGetDevice(&dev);
        hipDeviceGetAttribute(&cus, hipDeviceAttributeMultiprocessorCount, dev);
        hipFuncSetAttribute((const void*)fwd_megakernel, hipFuncAttributeMaxDynamicSharedMemorySize, LDS_BYTES);
        hipOccupancyMaxActiveBlocksPerMultiprocessor(&per_cu, (const void*)fwd_megakernel, 512, LDS_BYTES);
        if (per_cu < 1) { fprintf(stderr, "kernel_launch: occupancy query reports %d blocks per CU\n", per_cu); per_cu = 1; }
        grid_blocks = cus;
        (void)hipGetLastError();
    }
    Params p{};
    const float** pp = (const float**)&p;
    for (int i = 0; i < 23; ++i) pp[i] = (const float*)d_in[i];
    p.out = (float*)d_out; p.ws = (unsigned char*)d_ws;
    p.ph_lo = 0; p.ph_hi = NPHASE;
    (void)hipMemsetAsync((unsigned char*)d_ws + WS_CTL, 0, CTL_BYTES, stream);
    void* args[] = {&p};
    hipError_t e = hipLaunchCooperativeKernel((const void*)fwd_megakernel, dim3(grid_blocks), dim3(512), args, LDS_BYTES, stream);
    if (e != hipSuccess) fprintf(stderr, "cooperative launch failed: %s (grid %d)\n", hipGetErrorString(e), grid_blocks);
}
```

```cpp
#include <hip/hip_runtime.h>
#include <hip/hip_cooperative_groups.h>
#include <cstdio>
#include <cstdint>
namespace cg = cooperative_groups;

#define PROBE_REP 0
#define PROBE_SYNC 0
#define PROBE_MIX 0

#define LAS __attribute__((address_space(3)))
typedef unsigned short bf16_t;
typedef short bf16x8 __attribute__((ext_vector_type(8)));
typedef short s16x4 __attribute__((ext_vector_type(4)));
typedef float f32x4 __attribute__((ext_vector_type(4)));
typedef float f32x2 __attribute__((ext_vector_type(2)));
typedef float f32x16 __attribute__((ext_vector_type(16)));
typedef unsigned u32x4 __attribute__((ext_vector_type(4)));
typedef unsigned u32x2 __attribute__((ext_vector_type(2)));

constexpr int M = 16384, MCTX = 8192, D = 1024, FF = 2816, NGU = 2 * FF, NIN = 2304, NMOD = 9;
constexpr int NK_OFF = 16777216, NV_OFF = 25165824;
constexpr float EPS = 1e-6f;
constexpr float LOG2E = 1.4426950408889634f;

constexpr size_t MiB = 1u << 20;
constexpr size_t WS_MOD = 0;
constexpr size_t WS_CTL = 1 * MiB + 512 * 1024, CTL_BYTES = 16384;
constexpr size_t WS_PW = 1 * MiB + 256 * 1024;
constexpr size_t WS_SW = 1 * MiB;
constexpr size_t WS_CK = 2 * MiB;
constexpr size_t WS_CVT = 6 * MiB;
constexpr size_t WS_SSP = 10 * MiB;
constexpr size_t WS_BIAS = 11 * MiB;
constexpr size_t WS_SHB = 12 * MiB;
constexpr int NB = 13568;
constexpr size_t WS_W = 16 * MiB;
constexpr size_t W_GU_SZ = (size_t)NGU * D * 2, W_IN_SZ = (size_t)NIN * D * 2, W_D_SZ = (size_t)D * FF * 2, W_OUT_SZ = (size_t)D * D * 2;
constexpr size_t W_GU0 = 0, W_IN = W_GU_SZ, W_GU1 = W_IN + W_IN_SZ, W_D = W_GU1 + W_GU_SZ, W_OUT = W_D + 2 * W_D_SZ;
constexpr size_t W_LAYER = W_OUT + W_OUT_SZ;
constexpr size_t WS_H = 96 * MiB;
constexpr size_t WS_ACT = 128 * MiB;
constexpr size_t WS_ZA = 128 * MiB;
constexpr size_t WS_UT = 136 * MiB;
constexpr size_t WS_VGT = 144 * MiB;
constexpr size_t WS_Q = 152 * MiB;
constexpr size_t WS_K = 168 * MiB;
constexpr size_t WS_VT = 184 * MiB;
constexpr size_t WS_OB = 200 * MiB;
constexpr size_t WS_XB = 232 * MiB;
static_assert(WS_W + 2 * W_LAYER <= WS_H, "weights fit");

struct Params {
    const float *x_prompt, *x_sample, *cache_k, *cache_v, *c, *c_ctx, *ada_w, *ada_b, *norm_g;
    const float *w_gate, *w_up, *w_down, *w_in, *pool_w, *pool_scale, *q_norm_g, *k_norm_g, *na_rpb;
    const float *sg_vnorm_g, *sg_w, *sg_b, *out_norm_g, *w_out;
    float* out; unsigned char* ws;
    int ph_lo, ph_hi;
};

typedef __bf16 hbf16x2 __attribute__((ext_vector_type(2)));
__device__ __forceinline__ unsigned pk2(float lo, float hi) { const f32x2 v = {lo, hi}; const hbf16x2 b = __builtin_convertvector(v, hbf16x2); return __builtin_bit_cast(unsigned, b); }
__device__ __forceinline__ unsigned f2bf(float f) { return pk2(f, 0.f) & 0xffffu; }
typedef const __attribute__((address_space(4))) Params* KargPtr;
struct ECtx { KargPtr kp; int l, k; LAS unsigned char* lds_epi_; };
__device__ __forceinline__ float bf2f(unsigned short b) { return __builtin_bit_cast(float, (unsigned)b << 16); }
__device__ __forceinline__ float wave_sum(float v) {
#pragma unroll
    for (int o = 1; o < 64; o <<= 1) v += __shfl_xor(v, o);
    return v;
}
__device__ __forceinline__ float fast_sigmoid(float x) { return __builtin_amdgcn_rcpf(1.0f + __builtin_amdgcn_exp2f(-x * LOG2E)); }
__device__ __forceinline__ float silu_f(float x) { return x * fast_sigmoid(x); }
__device__ __forceinline__ float gelu_tanh(float x) { const float y = 0.7978845608028654f * (x + 0.044715f * x * x * x); return x * fast_sigmoid(2.0f * y); }
__device__ __forceinline__ int kind_of_row(int row) { return row < MCTX ? 0 : 1 + ((row - MCTX) >> 10); }

namespace pg8 {
constexpr int BM = 256, BK = 64, HALF = 128, HTB = HALF * BK * 2, STAGE_BYTES = 8 * HTB, NXCD = 8, WGM = 8;
__host__ __device__ __forceinline__ int lds_byte(int r, int c) { const int st = (r >> 4) * 2 + (c >> 5), rr = r & 15, cc = c & 31, ob = rr * 64 + cc * 2; return st * 1024 + (ob ^ (((ob >> 9) & 1) << 5)); }
__host__ __device__ __forceinline__ void stage_rc(int b, int& R, int& C) { const int st = b / 1024, sb = b % 1024, swz = sb ^ (((sb >> 9) & 1) << 5); R = (st >> 1) * 16 + swz / 64; C = (st & 1) * 32 + (swz % 64) / 2; }
struct Unit { int pm, pn; };
struct Gemm { const bf16_t* A; const bf16_t* Bt; int M, N, K; };
struct StaticOrder {
    int nM, nN, nwg, G, c; int exi, expm, expn;
    __device__ void init(int M_, int N_, int G_, int c_) { nM = M_ / BM; nN = N_ / BM; nwg = nM * nN; G = G_; c = c_; exi = -1; expm = 0; expn = 0; }
    __device__ bool next(int i, Unit& u) const {
        const long L = (long)i * G + c; if (L >= nwg) { if (i == exi) { u.pm = expm; u.pn = expn; return true; } return false; }
        int wgid = (int)L; { const int q = nwg / NXCD, r = nwg % NXCD, xcd = wgid % NXCD, off = wgid / NXCD; wgid = (xcd < r ? xcd * (q + 1) : r * (q + 1) + (xcd - r) * q) + off; }
        const int nig = WGM * nN, gid = wgid / nig, fm = gid * WGM, gsz = (nM - fm) < WGM ? (nM - fm) : WGM;
        u.pm = fm + ((wgid % nig) % gsz); u.pn = (wgid % nig) / gsz;
        if (nN == 9) u.pn = u.pn == 8 ? 0 : u.pn + 1;
        return true;
    }
};
template <class Epi>
__device__ __forceinline__ void gemm_phase(LAS unsigned char* lds, const int tid, const Gemm g, const StaticOrder& S, const Epi& E) {
    const int wid = __builtin_amdgcn_readfirstlane(tid >> 6), lane = tid & 63, wr = wid >> 2, wc = wid & 3, fr = lane & 15, fq = lane >> 4;
    const int K = g.K, nt = K / BK;
    unsigned voffA[2];
#pragma unroll
    for (int i = 0; i < 2; ++i) { int R, C; stage_rc(tid * 16 + i * 8192, R, C); voffA[i] = (unsigned)(R * K + C) * 2u; }
    const size_t kstep = (size_t)(BK * 2);
    const size_t hstep = (size_t)HALF * K * 2;
    const size_t tstep = 2 * hstep;
    const unsigned ldsw = (unsigned)wid * 1024u;
    const int aoff = lds_byte(wr * 64 + fr, fq * 8), boff = lds_byte(wc * 32 + fr, fq * 8);
#define PG8_SA(b, h) (((b) * 2 + (h)) * HTB)
#define PG8_SB(b, h) ((4 + (b) * 2 + (h)) * HTB)
#define PG8_STAGE(bufoff, gbase) do { _Pragma("unroll") for (int _i = 0; _i < 2; ++_i) \
        __builtin_amdgcn_global_load_lds((const unsigned*)((const char*)(gbase) + voffA[_i]), (LAS unsigned*)(lds + (bufoff) + ldsw + _i * 8192), 16, 0, 0); } while (0)
#define PG8_LDA(dst, b, h) do { _Pragma("unroll") for (int m = 0; m < 4; ++m) _Pragma("unroll") for (int k = 0; k < 2; ++k) dst[m][k] = *(const LAS bf16x8*)(lds + PG8_SA(b, h) + aoff + m * 2048 + k * 1024); } while (0)
#define PG8_LDB(dst, b, h) do { _Pragma("unroll") for (int n = 0; n < 2; ++n) _Pragma("unroll") for (int k = 0; k < 2; ++k) dst[n][k] = *(const LAS bf16x8*)(lds + PG8_SB(b, h) + boff + n * 2048 + k * 1024); } while (0)
#define PG8_MMA(ai, bj, At, Bt) do { __builtin_amdgcn_s_setprio(1); _Pragma("unroll") for (int m = 0; m < 4; ++m) _Pragma("unroll") for (int n = 0; n < 2; ++n) _Pragma("unroll") for (int k = 0; k < 2; ++k) \
        acc[ai][bj][m][n] = __builtin_amdgcn_mfma_f32_16x16x32_bf16(Bt[n][k], At[m][k], acc[ai][bj][m][n], 0, 0, 0); __builtin_amdgcn_s_setprio(0); } while (0)
#define PG8_WAIT_V(n) asm volatile("s_waitcnt vmcnt(" #n ")" ::: "memory")
#define PG8_WAIT_L(n) asm volatile("s_waitcnt lgkmcnt(" #n ")" ::: "memory")
#define PG8_BAR __builtin_amdgcn_s_barrier()
#define PG8_SCHED __builtin_amdgcn_sched_barrier(0)
    Unit cur, nxt; int ui = 0;
    if (!S.next(0, cur)) return;
    f32x4 acc[2][2][4][2];
#pragma unroll
    for (int a = 0; a < 2; ++a)
#pragma unroll
        for (int b = 0; b < 2; ++b)
#pragma unroll
            for (int m = 0; m < 4; ++m)
#pragma unroll
                for (int n = 0; n < 2; ++n) acc[a][b][m][n] = (f32x4){0.f, 0.f, 0.f, 0.f};
    bf16x8 At[4][2], B0[2][2], B1[2][2];
    const char* cA = (const char*)g.A + (size_t)cur.pm * tstep; const char* cB = (const char*)g.Bt + (size_t)cur.pn * tstep;
    PG8_STAGE(PG8_SB(0, 0), cB); PG8_STAGE(PG8_SB(0, 1), cB + hstep); PG8_STAGE(PG8_SA(0, 0), cA); PG8_STAGE(PG8_SA(0, 1), cA + hstep);
    if (wr == 1) PG8_BAR;
    PG8_WAIT_V(2); PG8_BAR;
    PG8_STAGE(PG8_SB(1, 0), cB + kstep); PG8_STAGE(PG8_SA(1, 0), cA + kstep); PG8_STAGE(PG8_SB(1, 1), cB + hstep + kstep);
    PG8_WAIT_V(6); PG8_BAR;
    for (;;) {
        const bool has_next = S.next(ui + 1, nxt);
        const char* nA = has_next ? (const char*)g.A + (size_t)nxt.pm * tstep : cA; const char* nB = has_next ? (const char*)g.Bt + (size_t)nxt.pn * tstep : cB;
        for (int t = 0; t < nt; t += 2) {
            const bool last = (t == nt - 2);
            const char* a1 = cA + (size_t)(t + 1) * kstep;
            const char* a2 = last ? nA : cA + (size_t)(t + 2) * kstep; const char* b2 = last ? nB : cB + (size_t)(t + 2) * kstep;
            const char* a3 = a2 + kstep; const char* b3 = b2 + kstep;
            PG8_LDB(B0, 0, 0); PG8_LDB(B1, 0, 1); PG8_SCHED; PG8_LDA(At, 0, 0); PG8_STAGE(PG8_SA(1, 1), a1 + hstep);
            PG8_WAIT_V(8); PG8_WAIT_L(0); PG8_BAR; PG8_MMA(0, 0, At, B0); PG8_MMA(0, 1, At, B1); PG8_BAR; PG8_SCHED;
            PG8_LDA(At, 0, 1); PG8_STAGE(PG8_SB(0, 0), b2); PG8_STAGE(PG8_SB(0, 1), b2 + hstep); PG8_STAGE(PG8_SA(0, 0), a2);
            PG8_WAIT_V(8); PG8_WAIT_L(0); PG8_BAR; PG8_MMA(1, 0, At, B0); PG8_MMA(1, 1, At, B1); PG8_BAR; PG8_SCHED;
            PG8_LDB(B0, 1, 0); PG8_LDB(B1, 1, 1); PG8_SCHED; PG8_LDA(At, 1, 0); PG8_STAGE(PG8_SA(0, 1), a2 + hstep);
            PG8_WAIT_V(8); PG8_WAIT_L(0); PG8_BAR; PG8_MMA(0, 0, At, B0); PG8_MMA(0, 1, At, B1); PG8_BAR; PG8_SCHED;
            PG8_LDA(At, 1, 1); PG8_STAGE(PG8_SB(1, 0), b3); PG8_STAGE(PG8_SB(1, 1), b3 + hstep); PG8_STAGE(PG8_SA(1, 0), a3);
            PG8_WAIT_V(8); PG8_WAIT_L(0); PG8_BAR; PG8_MMA(1, 0, At, B0); PG8_MMA(1, 1, At, B1); PG8_BAR; PG8_SCHED;
        }
        if (wr == 0) PG8_BAR;
        E(acc, cur, wr, wc, fr, fq);
        if (!has_next) break;
#pragma unroll
        for (int a = 0; a < 2; ++a)
#pragma unroll
            for (int b = 0; b < 2; ++b)
#pragma unroll
                for (int m = 0; m < 4; ++m)
#pragma unroll
                    for (int n = 0; n < 2; ++n) acc[a][b][m][n] = (f32x4){0.f, 0.f, 0.f, 0.f};
        cur = nxt; cA = nA; cB = nB; ++ui;
        if (wr == 1) PG8_BAR;
    }
    PG8_WAIT_V(0);
    PG8_BAR;
#undef PG8_SA
#undef PG8_SB
#undef PG8_STAGE
#undef PG8_LDA
#undef PG8_LDB
#undef PG8_MMA
#undef PG8_WAIT_V
#undef PG8_WAIT_L
#undef PG8_BAR
#undef PG8_SCHED
}
}

__device__ __forceinline__ float row_rstd(const float* ssp, int row) {
    const f32x4 a = *(const f32x4*)(ssp + (size_t)row * 4);
    return __builtin_amdgcn_rsqf(((a[0] + a[1]) + (a[2] + a[3])) * (1.0f / D) + EPS);
}
__device__ __forceinline__ float rstd_of(const f32x4 a) { return __builtin_amdgcn_rsqf(((a[0] + a[1]) + (a[2] + a[3])) * (1.0f / D) + EPS); }
struct EpiSwiglu {
    ECtx c;
    __device__ __forceinline__ void operator()(const f32x4 (&acc)[2][2][4][2], const pg8::Unit& u, int wr, int wc, int fr, int fq) const {
        unsigned char* ws = c.kp->ws;
        bf16_t* act = (bf16_t*)(ws + WS_ACT); const float* ssp = (const float*)(ws + WS_SSP);
        const float* bias = (const float*)(ws + WS_BIAS) + (size_t)c.l * 9 * NB + (c.k == 5 ? 7936 : 0);
        const int kind = u.pm < 32 ? 0 : 1 + ((u.pm - 32) >> 2);
        const float* bp = bias + (size_t)kind * NB + u.pn * 256 + wc * 32 + fq * 4;
        f32x4 bg[2], bu[2];
#pragma unroll
        for (int bj = 0; bj < 2; ++bj) { bg[bj] = *(const f32x4*)(bp + bj * 128); bu[bj] = *(const f32x4*)(bp + bj * 128 + 16); }
        const float* sbase = ssp + (size_t)(u.pm * 256 + wr * 64 + fr) * 4;
        f32x4 sn = *(const f32x4*)sbase;
#pragma unroll
        for (int ai = 0; ai < 2; ++ai)
#pragma unroll
            for (int m = 0; m < 4; ++m) {
                int row = u.pm * 256 + ai * 128 + wr * 64 + m * 16 + fr; asm volatile("" : "+v"(row));
                const float rs = rstd_of(sn);
                if (ai * 4 + m < 7) sn = *(const f32x4*)(sbase + (((m + 1) >> 2) + ai) * 512 + ((m + 1) & 3) * 64);
                bf16_t* rp = act + (size_t)row * FF + u.pn * 128 + wc * 32 + fq * 8;
                u32x4 w;
                { const f32x4 gg = acc[ai][0][m][0] * rs + bg[0], uu = acc[ai][0][m][1] * rs + bu[0];
                  w.x = pk2(silu_f(gg[0]) * uu[0], silu_f(gg[1]) * uu[1]); w.y = pk2(silu_f(gg[2]) * uu[2], silu_f(gg[3]) * uu[3]); }
                { const f32x4 gg = acc[ai][1][m][0] * rs + bg[1], uu = acc[ai][1][m][1] * rs + bu[1];
                  w.z = pk2(silu_f(gg[0]) * uu[0], silu_f(gg[1]) * uu[1]); w.w = pk2(silu_f(gg[2]) * uu[2], silu_f(gg[3]) * uu[3]); }
                *(u32x4*)rp = w;
            }
    }
};
struct EpiRes {
    ECtx c;
    __device__ __forceinline__ void operator()(const f32x4 (&acc)[2][2][4][2], const pg8::Unit& u, int wr, int wc, int fr, int fq) const {
        unsigned char* ws = c.kp->ws; float* xout = c.kp->out;
        const float* MOD = (const float*)(ws + WS_MOD); const float* modl = MOD + (size_t)c.l * 81 * 1024;
        const bool from_in = c.l == 0 && c.k == 1;
        const float* xin_ctx = c.kp->x_prompt; const float* xin_lat = c.kp->x_sample;
        const int gi = c.k == 4 ? 5 : (c.k == 1 ? 2 : 8); const float coef = c.k == 4 ? 1.0f : 0.5f;
        const int nsub = c.k == 4 ? 2 : (c.k == 1 ? 1 : 0), nl = c.k == 6 ? c.l + 1 : c.l;
        const float* ng = nl < 2 ? c.kp->norm_g + (size_t)(nl * 3 + nsub) * 1024 : nullptr;
        const float* nmod = MOD + (size_t)nl * 81 * 1024; const int nsc = 3 * nsub + 1;
        bf16_t* hn = (bf16_t*)(ws + WS_H); float* ssp = (float*)(ws + WS_SSP);
        LAS float* ssl = (LAS float*)c.lds_epi_;
        const int kind = u.pm < 32 ? 0 : 1 + ((u.pm - 32) >> 2);
        const float* gv = modl + (size_t)(kind * 9 + gi) * 1024;
        const int col0 = u.pn * 256 + wc * 32 + fq * 8;
        f32x4 gt[2][2], gs[2][2];
#pragma unroll
        for (int bj = 0; bj < 2; ++bj)
#pragma unroll
            for (int n = 0; n < 2; ++n) {
                gt[bj][n] = *(const f32x4*)(gv + col0 + bj * 128 + n * 4) * coef;
                if (ng) gs[bj][n] = *(const f32x4*)(ng + col0 + bj * 128 + n * 4) * (*(const f32x4*)(nmod + (size_t)(kind * 9 + nsc) * 1024 + col0 + bj * 128 + n * 4) + 1.0f);
            }
        const float* xin = u.pm < 32 ? xin_ctx : xin_lat;
        const int rbase = (u.pm < 32 ? u.pm : u.pm - 32) * 256;
        bf16_t* xb = (bf16_t*)(ws + WS_XB);
        const bool is_last = nl >= 2;
        u32x4 xnb[2];
        if (!from_in) { const bf16_t* xp0 = xb + (size_t)(u.pm * 256 + wr * 64 + fr) * D + col0;
#pragma unroll
            for (int bj = 0; bj < 2; ++bj) xnb[bj] = *(const u32x4*)(xp0 + bj * 128); }
#pragma unroll
        for (int ai = 0; ai < 2; ++ai)
#pragma unroll
            for (int m = 0; m < 4; ++m) {
                int rl = ai * 128 + wr * 64 + m * 16 + fr; asm volatile("" : "+v"(rl));
                const float* ip = xin + (size_t)(rbase + rl) * D + col0;
                float* op = xout + (size_t)(u.pm * 256 + rl) * D + col0;
                bf16_t* hp = hn + (size_t)(u.pm * 256 + rl) * D + col0;
                bf16_t* xp = xb + (size_t)(u.pm * 256 + rl) * D + col0;
                f32x4 xc[2][2];
                if (from_in) {
#pragma unroll
                    for (int bj = 0; bj < 2; ++bj)
#pragma unroll
                        for (int n = 0; n < 2; ++n) xc[bj][n] = __builtin_nontemporal_load((const f32x4*)(ip + bj * 128 + n * 4));
                } else {
#pragma unroll
                    for (int bj = 0; bj < 2; ++bj)
#pragma unroll
                        for (int n = 0; n < 2; ++n) { const unsigned wx_ = n ? xnb[bj].z : xnb[bj].x, wy_ = n ? xnb[bj].w : xnb[bj].y;
                            xc[bj][n] = (f32x4){__builtin_bit_cast(float, wx_ << 16), __builtin_bit_cast(float, wx_ & 0xffff0000u), __builtin_bit_cast(float, wy_ << 16), __builtin_bit_cast(float, wy_ & 0xffff0000u)}; }
                    if (ai * 4 + m < 7) { const bf16_t* xpn = xp + (size_t)((m == 3 ? 128 - 48 : 16)) * D;
#pragma unroll
                        for (int bj = 0; bj < 2; ++bj) xnb[bj] = *(const u32x4*)(xpn + bj * 128); }
                }
                float ss = 0.f;
#pragma unroll
                for (int bj = 0; bj < 2; ++bj) {
                    const f32x4 x0 = xc[bj][0] + gt[bj][0] * acc[ai][bj][m][0], x1 = xc[bj][1] + gt[bj][1] * acc[ai][bj][m][1];
                    if (is_last) { __builtin_nontemporal_store(x0, (f32x4*)(op + bj * 128)); __builtin_nontemporal_store(x1, (f32x4*)(op + bj * 128 + 4)); }
                    else { u32x4 wx; wx.x = pk2(x0[0], x0[1]); wx.y = pk2(x0[2], x0[3]); wx.z = pk2(x1[0], x1[1]); wx.w = pk2(x1[2], x1[3]); *(u32x4*)(xp + bj * 128) = wx; }
                    if (ng) {
                        ss += ((x0[0] * x0[0] + x0[1] * x0[1]) + (x0[2] * x0[2] + x0[3] * x0[3])) + ((x1[0] * x1[0] + x1[1] * x1[1]) + (x1[2] * x1[2] + x1[3] * x1[3]));
                        const f32x4 h0 = x0 * gs[bj][0], h1 = x1 * gs[bj][1];
                        u32x4 wh; wh.x = pk2(h0[0], h0[1]); wh.y = pk2(h0[2], h0[3]); wh.z = pk2(h1[0], h1[1]); wh.w = pk2(h1[2], h1[3]);
                        *(u32x4*)(hp + bj * 128) = wh;
                    }
                }
                if (ng) {
                    ss += __shfl_xor(ss, 16); ss += __shfl_xor(ss, 32);
                    if (fq == 0) ssl[rl * 4 + wc] = ss;
                }
            }
        if (ng) {
            asm volatile("s_waitcnt lgkmcnt(0)" ::: "memory"); __builtin_amdgcn_s_barrier(); asm volatile("" ::: "memory");
            const int t = wr * 256 + wc * 64 + fq * 16 + fr;
            if (t < 256) { const f32x4 a = *(const LAS f32x4*)(ssl + t * 4); ssp[(size_t)(u.pm * 256 + t) * 4 + u.pn] = (a[0] + a[1]) + (a[2] + a[3]); }
        }
    }
};
struct EpiBias {
    ECtx c;
    __device__ __forceinline__ void operator()(const f32x4 (&acc)[2][2][4][2], const pg8::Unit& u, int wr, int wc, int fr, int fq) const {
        float* bias = (float*)(c.kp->ws + WS_BIAS) + (size_t)c.l * 9 * NB;
        const int which = u.pn < 22 ? 0 : (u.pn < 31 ? 1 : 2);
        if (wr != 0) return;
#pragma unroll
        for (int m = 0; m < 2; ++m) {
            const int kind = m * 16 + fr - 9 * which;
            if (kind >= 0 && kind < 9) {
#pragma unroll
                for (int bj = 0; bj < 2; ++bj)
#pragma unroll
                    for (int n = 0; n < 2; ++n) *(f32x4*)(bias + (size_t)kind * NB + u.pn * 256 + bj * 128 + wc * 32 + n * 16 + fq * 4) = acc[0][bj][m][n];
            }
        }
    }
};
struct EpiIn {
    ECtx c;
    __device__ __forceinline__ void operator()(const f32x4 (&acc)[2][2][4][2], const pg8::Unit& u, int wr, int wc, int fr, int fq) const {
        unsigned char* ws = c.kp->ws; float* out = c.kp->out; const int layer = c.l;
        const float* qg = c.kp->q_norm_g + layer * 64; const float* kg = c.kp->k_norm_g + layer * 64; const float* vng = c.kp->sg_vnorm_g + layer * 256;
        const float* ssp = (const float*)(ws + WS_SSP); const float* bias = (const float*)(ws + WS_BIAS) + (size_t)layer * 9 * NB + 5632;
        const int pn = u.pn;
        const int kind = u.pm < 32 ? 0 : 1 + ((u.pm - 32) >> 2);
        const float* sbase = ssp + (size_t)(u.pm * 256 + wr * 64 + fr) * 4;
        f32x4 sn = *(const f32x4*)sbase;
        f32x4 bz[2][2];
#pragma unroll
        for (int bj = 0; bj < 2; ++bj)
#pragma unroll
            for (int n = 0; n < 2; ++n) bz[bj][n] = *(const f32x4*)(bias + (size_t)kind * NB + pn * 256 + bj * 128 + wc * 32 + n * 16 + fq * 4);
#pragma unroll
        for (int ai = 0; ai < 2; ++ai)
#pragma unroll
            for (int m = 0; m < 4; ++m) {
                int row = u.pm * 256 + ai * 128 + wr * 64 + m * 16 + fr; asm volatile("" : "+v"(row));
                const float rs = rstd_of(sn);
                if (ai * 4 + m < 7) sn = *(const f32x4*)(sbase + (((m + 1) >> 2) + ai) * 512 + ((m + 1) & 3) * 64);
                f32x4 v[2][2];
#pragma unroll
                for (int bj = 0; bj < 2; ++bj)
#pragma unroll
                    for (int n = 0; n < 2; ++n) v[bj][n] = acc[ai][bj][m][n] * rs + bz[bj][n];
#define PK8(dst16, x0, x1) do { u32x4 w_; w_.x = pk2((x0)[0], (x0)[1]); w_.y = pk2((x0)[2], (x0)[3]); w_.z = pk2((x1)[0], (x1)[1]); w_.w = pk2((x1)[2], (x1)[3]); *(u32x4*)(dst16) = w_; } while (0)
                if (pn == 0) {
                    bf16_t* za = (bf16_t*)(ws + WS_ZA) + (size_t)row * 256 + wc * 64 + fq * 8;
#pragma unroll
                    for (int bj = 0; bj < 2; ++bj) PK8(za + bj * 32, v[bj][0], v[bj][1]);
                } else if (pn <= 4) {
                    const bool isk = pn >= 3; const int h = (isk ? pn - 3 : pn - 1) * 4 + wc;
                    bf16_t* qb = (bf16_t*)(ws + WS_Q); bf16_t* kb = (bf16_t*)(ws + WS_K);
                    float ss = 0.f;
#pragma unroll
                    for (int bj = 0; bj < 2; ++bj)
#pragma unroll
                        for (int n = 0; n < 2; ++n) ss += (v[bj][n][0] * v[bj][n][0] + v[bj][n][1] * v[bj][n][1]) + (v[bj][n][2] * v[bj][n][2] + v[bj][n][3] * v[bj][n][3]);
                    ss += __shfl_xor(ss, 16); ss += __shfl_xor(ss, 32);
                    const float rstd = __builtin_amdgcn_rsqf(ss * (1.0f / 64.0f) + EPS);
                    const float* gn = isk ? kg : qg;
                    bf16_t* dst = isk ? kb + ((size_t)h * M + (row & ~31)) * 64 + (fq >> 1) * 512 + (row & 31) * 16 + (fq & 1) * 8 : qb + ((size_t)h * M + row) * 64 + fq * 8;
#pragma unroll
                    for (int bj = 0; bj < 2; ++bj) {
                        const int dd = bj * 32 + fq * 8;
                        const float qs = isk ? rstd : rstd * (0.125f * LOG2E);
                        const f32x4 o0 = v[bj][0] * qs * *(const f32x4*)(gn + dd), o1 = v[bj][1] * qs * *(const f32x4*)(gn + dd + 4);
                        PK8(dst + (isk ? bj * 1024 : bj * 32), o0, o1);
                        if (isk && row < MCTX) { float* nk = out + NK_OFF + ((((size_t)(row >> 8) * 2 + layer) * 8 + h) * 256 + (row & 255)) * 64 + dd; __builtin_nontemporal_store(o0, (f32x4*)nk); __builtin_nontemporal_store(o1, (f32x4*)(nk + 4)); }
                    }
                } else if (pn <= 6) {
                    const int h = (pn - 5) * 4 + wc;
                    bf16_t* vt = (bf16_t*)(ws + WS_VT);
                    bf16_t* vrow = vt + ((size_t)h * M + (row & ~31)) * 64 + ((row >> 3) & 1) * 512 + ((row >> 4) & 1) * 8 + (row & 7) + fq * 128;
#pragma unroll
                    for (int bj = 0; bj < 2; ++bj)
#pragma unroll
                        for (int n = 0; n < 2; ++n) {
#pragma unroll
                            for (int j = 0; j < 4; ++j) vrow[bj * 1024 + n * 64 + j * 16] = (bf16_t)f2bf(v[bj][n][j]);
                            if (row < MCTX) __builtin_nontemporal_store(v[bj][n], (f32x4*)(out + NV_OFF + ((((size_t)(row >> 8) * 2 + layer) * 8 + h) * 256 + (row & 255)) * 64 + bj * 32 + fq * 8 + n * 4));
                        }
                } else if (pn == 7) {
                    bf16_t* ut = (bf16_t*)(ws + WS_UT) + (size_t)row * 256 + wc * 64 + fq * 8;
#pragma unroll
                    for (int bj = 0; bj < 2; ++bj) {
                        f32x4 g0, g1;
#pragma unroll
                        for (int j = 0; j < 4; ++j) { g0[j] = gelu_tanh(v[bj][0][j]); g1[j] = gelu_tanh(v[bj][1][j]); }
                        PK8(ut + bj * 32, g0, g1);
                    }
                } else {
                    float ss = 0.f;
#pragma unroll
                    for (int bj = 0; bj < 2; ++bj)
#pragma unroll
                        for (int n = 0; n < 2; ++n) {
#pragma unroll
                            for (int j = 0; j < 4; ++j) { v[bj][n][j] = gelu_tanh(v[bj][n][j]); ss += v[bj][n][j] * v[bj][n][j]; }
                        }
                    ss += __shfl_xor(ss, 16); ss += __shfl_xor(ss, 32);
                    const float rstd = __builtin_amdgcn_rsqf(ss * (1.0f / 64.0f) + EPS);
                    bf16_t* vgt = (bf16_t*)(ws + WS_VGT);
                    bf16_t* vgrow = vgt + (size_t)(row >> 7) * 32768 + ((row >> 4) & 7) * 512 + ((row >> 3) & 1) * 8 + (row & 7) + wc * 8192 + fq * 128;
#pragma unroll
                    for (int bj = 0; bj < 2; ++bj)
#pragma unroll
                        for (int n = 0; n < 2; ++n) {
                            const f32x4 o = v[bj][n] * rstd * *(const f32x4*)(vng + wc * 64 + bj * 32 + fq * 8 + n * 4);
#pragma unroll
                            for (int j = 0; j < 4; ++j) vgrow[bj * 4096 + n * 64 + j * 16] = (bf16_t)f2bf(o[j]);
                        }
                }
#undef PK8
            }
    }
};

struct EpiAll {
    ECtx c0;
    __device__ __forceinline__ void operator()(const f32x4 (&acc)[2][2][4][2], const pg8::Unit& u, int wr, int wc, int fr, int fq) const {
        ECtx c = c0; asm volatile("" : "+s"(c.kp));
        if (u.pm < 0) { ECtx cb = c; cb.l = 1; pg8::Unit ub; ub.pm = 0; ub.pn = u.pn - 48; EpiBias{cb}(acc, ub, wr, wc, fr, fq); }
        else if (c.k == 0 || c.k == 5) EpiSwiglu{c}(acc, u, wr, wc, fr, fq); else if (c.k == 2) EpiIn{c}(acc, u, wr, wc, fr, fq); else if (c.k < 0) EpiBias{c}(acc, u, wr, wc, fr, fq); else EpiRes{c}(acc, u, wr, wc, fr, fq);
    }
};
struct Frame {
    LAS unsigned char* lds;
    int tid, lane, wave, G, bid;
};

__device__ __forceinline__ void transpose_item(const float* src  , int sstride, int K, bf16_t* WT, int n0, int k0, LAS float* scr, int lane) {
    float tv[32];
#pragma unroll
    for (int i = 0; i < 32; ++i) tv[i] = __builtin_nontemporal_load(src + (size_t)(k0 + 2 * i + (lane >> 5)) * sstride);
#pragma unroll
    for (int i = 0; i < 32; ++i) scr[(2 * i + (lane >> 5)) * 33 + (lane & 31)] = tv[i];
    asm volatile("s_waitcnt lgkmcnt(0)" ::: "memory");
    const int c = lane & 7;
#pragma unroll
    for (int j = 0; j < 4; ++j) { const int n = (lane >> 3) + 8 * j; const LAS float* s = scr + (8 * c) * 33 + n;
        u32x4 o; o.x = pk2(s[0 * 33], s[1 * 33]); o.y = pk2(s[2 * 33], s[3 * 33]); o.z = pk2(s[4 * 33], s[5 * 33]); o.w = pk2(s[6 * 33], s[7 * 33]);
        *(u32x4*)(WT + (size_t)(n0 + n) * K + k0 + 8 * c) = o; }
    asm volatile("s_waitcnt lgkmcnt(0)" ::: "memory");
}

constexpr int CV_GU = 16 * 176, CV_D = 44 * 32, CV_IN = 16 * 72, CV_OUT = 16 * 32, CV_NA = 2 * CV_GU + CV_IN, CV_LAYER = CV_NA + 2 * CV_D + CV_OUT;
__device__ __forceinline__ void convert_items(const Params& p, Frame& F, int l, int lo, int hi, int widx, int nw) {
    LAS float* scr = (LAS float*)(F.lds + F.wave * 16896);
    unsigned char* wl = p.ws + WS_W + (size_t)l * W_LAYER;
    const int q = F.lane & 31;
    for (int it = lo + widx; it < hi; it += nw) {
        int r = it;
        if (r < 2 * CV_GU) {
            const int f = r / CV_GU; r %= CV_GU; const int kb = r / 176, nb = r % 176, n0 = nb * 32;
            const int tile = n0 >> 8, p0 = n0 & 255, ffcol = tile * 128 + 32 * ((p0 >> 5) & 3) + 8 * ((q & 15) >> 2) + 4 * (p0 >> 7) + (q & 3);
            const float* src = ((q >> 4) ? p.w_up : p.w_gate) + (size_t)(l * 2 + f) * D * FF + ffcol;
            transpose_item(src, FF, D, (bf16_t*)(wl + (f ? W_GU1 : W_GU0)), n0, kb * 64, scr, F.lane); continue; }
        r -= 2 * CV_GU;
        if (r < CV_IN) {
            const int kb = r / 72, nb = r % 72, n0 = nb * 32, p0 = n0 & 255;
            const int lcol = (n0 & ~255) + 64 * ((p0 >> 5) & 3) + 32 * (p0 >> 7) + 8 * ((q & 15) >> 2) + 4 * (q >> 4) + (q & 3);
            const float* src = p.w_in + (size_t)l * D * NIN + lcol;
            transpose_item(src, NIN, D, (bf16_t*)(wl + W_IN), n0, kb * 64, scr, F.lane); continue; }
        r -= CV_IN;
        if (r < 2 * CV_D) {
            const int f = r / CV_D; r %= CV_D; const int kb = r / 32, nb = r % 32, n0 = nb * 32;
            const float* src = p.w_down + (size_t)(l * 2 + f) * FF * D + n0 + (8 * ((q & 15) >> 2) + 4 * (q >> 4) + (q & 3));
            transpose_item(src, D, FF, (bf16_t*)(wl + W_D + f * W_D_SZ), n0, kb * 64, scr, F.lane); continue; }
        r -= 2 * CV_D;
        { const int kb = r / 32, nb = r % 32, n0 = nb * 32;
          const float* src = p.w_out + (size_t)l * D * D + n0 + (8 * ((q & 15) >> 2) + 4 * (q >> 4) + (q & 3));
          transpose_item(src, D, D, (bf16_t*)(wl + W_OUT), n0, kb * 64, scr, F.lane); }
    }
}

__device__ __forceinline__ void phase_prologue(const Params& p, Frame& F) {
    float* MOD = (float*)(p.ws + WS_MOD);
    for (int item = F.bid; item < 144; item += F.G) {
        const int l = item / 72, jc = item % 72;
        LAS float* sc = (LAS float*)F.lds; LAS float* red = sc + 9 * 1024;
        for (int i = F.tid; i < 9 * 1024; i += 512) { const int s = i >> 10, k = i & 1023; const float v = s == 0 ? p.c_ctx[k] : p.c[(s - 1) * 1024 + k]; sc[i] = silu_f(v); }
        __syncthreads();
        const float* w = p.ada_w + (size_t)l * 1024 * 9216 + (size_t)(F.wave * 128) * 9216 + jc * 128 + F.lane * 2;
        f32x2 acc[9];
#pragma unroll
        for (int s = 0; s < 9; ++s) acc[s] = (f32x2){0.f, 0.f};
        for (int k0 = 0; k0 < 128; k0 += 32) {
            f32x2 wv[32];
#pragma unroll
            for (int k = 0; k < 32; ++k) wv[k] = __builtin_nontemporal_load((const f32x2*)(w + (size_t)(k0 + k) * 9216));
#pragma unroll
            for (int k = 0; k < 32; ++k) {
#pragma unroll
                for (int s = 0; s < 9; ++s) acc[s] += sc[s * 1024 + F.wave * 128 + k0 + k] * wv[k];
            }
        }
#pragma unroll
        for (int s = 0; s < 9; ++s) { red[(F.wave * 9 + s) * 128 + F.lane * 2] = acc[s].x; red[(F.wave * 9 + s) * 128 + F.lane * 2 + 1] = acc[s].y; }
        __syncthreads();
        for (int i = F.tid; i < 9 * 128; i += 512) { const int s = i >> 7, j = i & 127; float sum = p.ada_b[l * 9216 + jc * 128 + j];
#pragma unroll
            for (int w8 = 0; w8 < 8; ++w8) sum += red[(w8 * 9 + s) * 128 + j];
            MOD[(size_t)(l * 9 + s) * 9216 + jc * 128 + j] = sum;
            const int mi = jc >> 3;
            if (mi % 3 == 0) ((bf16_t*)(p.ws + WS_SHB))[((size_t)l * 256 + 9 * (mi / 3) + s) * 1024 + (jc & 7) * 128 + j] = (bf16_t)f2bf(sum); }
        __syncthreads();
    }
    const int gw = F.bid * 8 + F.wave, NGW = F.G * 8;
    LAS float* scr = (LAS float*)(F.lds + F.wave * 16896);
    { unsigned* z = (unsigned*)(p.ws + WS_SHB);
      for (int i = gw * 64 + F.lane; i < 2 * 229 * 512; i += NGW * 64) { const int l = i / (229 * 512), r = i % (229 * 512); z[((size_t)l * 256 + 27) * 512 + r] = 0u; } }
    { bf16_t* SW = (bf16_t*)(p.ws + WS_SW);
      for (int i = gw * 64 + F.lane; i < 2 * 4 * 128 * 128 / 2; i += NGW * 64) { const f32x2 v = *(const f32x2*)(p.sg_w + 2 * (size_t)i); ((unsigned*)SW)[i] = pk2(v.x, v.y); } }
    { bf16_t* PW = (bf16_t*)(p.ws + WS_PW);
      for (int i = gw * 64 + F.lane; i < 2 * 4 * 64 * 64; i += NGW * 64) { const int c = i & 63, d = (i >> 6) & 63, lg = i >> 12; PW[i] = (bf16_t)f2bf(p.pool_w[((size_t)lg * 64 + c) * 64 + d]); } }
    { bf16_t* CK = (bf16_t*)(p.ws + WS_CK); bf16_t* CVT = (bf16_t*)(p.ws + WS_CVT);
      const bool split = F.G == 256;
      const int cw = split ? gw - 144 * 8 : gw, cnw = split ? (256 - 144) * 8 : NGW;
      if (cw >= 0)
      for (int it = cw; it < 128 * 4; it += cnw) {
          const int mat = it >> 2, t0 = (it & 3) * 64;
          const float* ks = p.cache_k + ((size_t)mat * 256 + t0) * 64; const float* vs = p.cache_v + ((size_t)mat * 256 + t0) * 64;
          const int d = F.lane;
          for (int tq = 0; tq < 64; tq += 16) {
              float kv[16], vv[16];
#pragma unroll
              for (int t = 0; t < 16; ++t) { kv[t] = __builtin_nontemporal_load(ks + (tq + t) * 64 + d); vv[t] = __builtin_nontemporal_load(vs + (tq + t) * 64 + d); }
#pragma unroll
              for (int t = 0; t < 16; ++t) {
                  const int tt = t0 + tq + t, key = tt & 31; const size_t tb = ((size_t)mat * 8 + (tt >> 5)) * 2048;
                  CK[tb + ((d >> 4) * 32 + key) * 16 + (d & 15)] = (bf16_t)f2bf(kv[t]);
                  CVT[tb + (((d >> 5) * 2 + ((key >> 3) & 1)) * 32 + (d & 31)) * 16 + (key >> 4) * 8 + (key & 7)] = (bf16_t)f2bf(vv[t]);
              }
          }
      } }
    convert_items(p, F, 0, 0, CV_NA, gw, NGW);
    if (F.G != 256) { convert_items(p, F, 0, CV_NA, CV_LAYER, gw, NGW); convert_items(p, F, 1, 0, CV_LAYER, gw, NGW); }
}

__device__ __forceinline__ void phase_norm0(const Params& p, Frame& F) {
    bf16_t* H = (bf16_t*)(p.ws + WS_H); float* SSP = (float*)(p.ws + WS_SSP);
    const float* modl = (const float*)(p.ws + WS_MOD);
    const bool split = F.G == 256;
    if (split && F.bid < 53) return;
    const int gw = (split ? F.bid - 53 : F.bid) * 8 + F.wave, NGW = (split ? F.G - 53 : F.G) * 8;
    for (int r0 = gw * 8; r0 < M; r0 += NGW * 8) {
        const int kind = kind_of_row(r0);
        const float* sc = modl + (size_t)(kind * 9 + 1) * 1024;
        f32x4 gs[4];
#pragma unroll
        for (int j = 0; j < 4; ++j) { const int col = 4 * F.lane + 256 * j; gs[j] = *(const f32x4*)(p.norm_g + col) * (*(const f32x4*)(sc + col) + 1.0f); }
#pragma unroll 4
        for (int rr = 0; rr < 8; ++rr) {
            const int row = r0 + rr;
            const float* xr = row < MCTX ? p.x_prompt + (size_t)row * D : p.x_sample + (size_t)(row - MCTX) * D;
            f32x4 v[4]; float s = 0.f;
#pragma unroll
            for (int j = 0; j < 4; ++j) { v[j] = __builtin_nontemporal_load((const f32x4*)(xr + 4 * F.lane + 256 * j)); s += (v[j][0] * v[j][0] + v[j][1] * v[j][1]) + (v[j][2] * v[j][2] + v[j][3] * v[j][3]); }
            s = wave_sum(s);
            if (F.lane < 4) SSP[(size_t)row * 4 + F.lane] = F.lane == 0 ? s : 0.f;
#pragma unroll
            for (int j = 0; j < 4; ++j) { const f32x4 o = v[j] * gs[j]; u32x2 w; w.x = pk2(o[0], o[1]); w.y = pk2(o[2], o[3]);
                *(u32x2*)(H + (size_t)row * D + 4 * F.lane + 256 * j) = w; }
        }
    }
}

__device__ __forceinline__ float half_max(float v) {
    const auto rr = __builtin_amdgcn_permlane32_swap(__builtin_bit_cast(unsigned, v), __builtin_bit_cast(unsigned, v), false, false);
    return fmaxf(__builtin_bit_cast(float, (unsigned)rr[0]), __builtin_bit_cast(float, (unsigned)rr[1]));
}
__device__ __forceinline__ float half_sum(float v) {
    const auto rr = __builtin_amdgcn_permlane32_swap(__builtin_bit_cast(unsigned, v), __builtin_bit_cast(unsigned, v), false, false);
    return __builtin_bit_cast(float, (unsigned)rr[0]) + __builtin_bit_cast(float, (unsigned)rr[1]);
}
struct AttnState { f32x16 O0, O1; float m, l; };
struct KF { bf16x8 k[4]; };
struct VF { bf16x8 v[2][2]; };
__device__ __forceinline__ void load_k(KF& f, const bf16_t* Kp, int lane) {
    const int rho = lane & 31, key = 16 * ((rho >> 2) & 1) + 4 * (rho >> 3) + (rho & 3);
    const bf16_t* kp = Kp + key * 16 + (lane >> 5) * 8;
#pragma unroll
    for (int c = 0; c < 4; ++c) f.k[c] = *(const bf16x8*)(kp + 512 * c);
}
__device__ __forceinline__ void load_v(VF& f, const bf16_t* Vp, int lane) {
    const bf16_t* vp = Vp + (lane & 31) * 16 + (lane >> 5) * 8;
#pragma unroll
    for (int mb = 0; mb < 2; ++mb)
#pragma unroll
        for (int c = 0; c < 2; ++c) f.v[mb][c] = *(const bf16x8*)(vp + (mb * 2 + c) * 512);
}
template <bool LOCAL>
__device__ __forceinline__ f32x16 qk_part(const bf16x8 (&qf)[4], const KF& f, int lane, const LAS float* bl, int th, int qc, int cs) {
    const int g = lane >> 5;
    f32x16 S;
#pragma unroll
    for (int i = 0; i < 16; ++i) S[i] = 0.f;
#pragma unroll
    for (int c = 0; c < 4; ++c) S = __builtin_amdgcn_mfma_f32_32x32x16_bf16(f.k[c], qf[c], S, 0, 0, 0);
    if (LOCAL) {
        const LAS float* bp = bl + (63 + th * 32 + 16 * g - qc);
        const int rel0 = th * 32 + 16 * g - cs;
        float bv[16];
#pragma unroll
        for (int i = 0; i < 16; ++i) bv[i] = bp[i];
#pragma unroll
        for (int i = 0; i < 16; ++i) {
            const float pen = (unsigned)(rel0 + i) < 16u ? 0.f : -1e30f;
            S[i] = (S[i] + bv[i]) + pen;
        }
    }
    return S;
}
__device__ __forceinline__ void pv_part(AttnState& st, f32x16 S, const VF& f) {
    float mt = S[0];
#pragma unroll
    for (int i = 1; i < 16; ++i) mt = fmaxf(mt, S[i]);
    mt = half_max(mt);
    if (__any(mt - st.m > 8.0f)) {
        const float mn = fmaxf(st.m, mt);
        const float alpha = __builtin_amdgcn_exp2f(st.m - mn);
        st.m = mn; st.l *= alpha;
#pragma unroll
        for (int i = 0; i < 16; ++i) { st.O0[i] *= alpha; st.O1[i] *= alpha; }
    }
    float ps = 0.f;
#pragma unroll
    for (int i = 0; i < 16; ++i) { S[i] = __builtin_amdgcn_exp2f(S[i] - st.m); ps += S[i]; }
    st.l += ps;
    bf16x8 pf[2];
#pragma unroll
    for (int c = 0; c < 2; ++c) {
        u32x4 w; w.x = pk2(S[8 * c + 0], S[8 * c + 1]); w.y = pk2(S[8 * c + 2], S[8 * c + 3]); w.z = pk2(S[8 * c + 4], S[8 * c + 5]); w.w = pk2(S[8 * c + 6], S[8 * c + 7]);
        pf[c] = __builtin_bit_cast(bf16x8, w);
    }
#define VFR(mb, c) (f.v[mb][c])
    st.O0 = __builtin_amdgcn_mfma_f32_32x32x16_bf16(VFR(0, 0), pf[0], st.O0, 0, 0, 0);
    st.O0 = __builtin_amdgcn_mfma_f32_32x32x16_bf16(VFR(0, 1), pf[1], st.O0, 0, 0, 0);
    st.O1 = __builtin_amdgcn_mfma_f32_32x32x16_bf16(VFR(1, 0), pf[0], st.O1, 0, 0, 0);
    st.O1 = __builtin_amdgcn_mfma_f32_32x32x16_bf16(VFR(1, 1), pf[1], st.O1, 0, 0, 0);
#undef VFR
}
template <bool LOCAL>
__device__ __forceinline__ void attn_run(AttnState& st, const bf16x8 (&qf)[4], const bf16_t* K0, const bf16_t* V0, int ntiles, int lane,
                                         const LAS float* rpbL, int r, int start, int qc, int cs) {
    KF ka, kb; VF va, vb;
    load_k(ka, K0, lane); load_v(va, V0, lane);
    for (int t = 0; t < ntiles; t += 2) {
        const LAS float* bl = rpbL + (start + (t >> 1) - r + 7) * 128;
        load_k(kb, K0 + (size_t)(t + 1) * 2048, lane);
        f32x16 S = qk_part<LOCAL>(qf, ka, lane, bl, 0, qc, cs);
        load_v(vb, V0 + (size_t)(t + 1) * 2048, lane);
        pv_part(st, S, va);
        const int tn = t + 2 < ntiles ? t + 2 : 0;
        load_k(ka, K0 + (size_t)tn * 2048, lane);
        S = qk_part<LOCAL>(qf, kb, lane, bl, 1, qc, cs);
        load_v(va, V0 + (size_t)tn * 2048, lane);
        pv_part(st, S, vb);
    }
}
__device__ __forceinline__ void attn_finish(Frame& F, AttnState& st, int q0, int h, const float* gb  , bf16_t* OB) {
    const int g = F.lane >> 5, ql = F.lane & 31;
    const float lt = half_sum(st.l);
    const float inv = 1.0f / lt;
    float ss = 0.f;
#pragma unroll
    for (int i = 0; i < 16; ++i) { st.O0[i] *= inv; st.O1[i] *= inv; ss += st.O0[i] * st.O0[i] + st.O1[i] * st.O1[i]; }
    ss = half_sum(ss);
    LAS float* hs = (LAS float*)(F.lds + 61440);
    if (g == 0) hs[h * 32 + ql] = ss;
    __syncthreads();
    float tot = 0.f;
#pragma unroll
    for (int hh = 0; hh < 8; ++hh) tot += hs[hh * 32 + ql];
    const float rstd = __builtin_amdgcn_rsqf(tot * (1.0f / 512.0f) + EPS);
    bf16_t* orow = OB + (size_t)(q0 + ql) * D + 256 + h * 64;
#pragma unroll
    for (int mb = 0; mb < 2; ++mb)
#pragma unroll
        for (int i = 0; i < 4; ++i) {
            const int d = 32 * mb + 8 * i + 4 * g;
            const f32x4 gv = *(const f32x4*)(gb + h * 64 + d);
            float o[4];
#pragma unroll
            for (int j = 0; j < 4; ++j) o[j] = (mb == 0 ? st.O0[4 * i + j] : st.O1[4 * i + j]) * rstd * gv[j];
            u32x2 w; w.x = pk2(o[0], o[1]); w.y = pk2(o[2], o[3]);
            *(u32x2*)(orow + d) = w;
        }
    __syncthreads();
}

__device__ __forceinline__ void pool_unit(const Params& p, Frame& F, int l, int u, const bf16_t* ZA, const bf16_t* PWT, bf16_t* OB, const float* ong) {
    const int lane = F.lane, g2 = lane >> 5, ql = lane & 31, w = F.wave;
    const int row0 = u * 32;
    const int seq0 = row0 < MCTX ? (row0 & ~255) : MCTX + ((row0 - MCTX) & ~1023);
    const int L = row0 < MCTX ? 256 : 1024, tloc = row0 - seq0;
    LAS float* A = (LAS float*)F.lds;
    LAS float* P = A + 48 * 256;
    LAS float* part = P + 32 * 260;
    bf16x8 af[4];
    { const bf16_t* ap = PWT + ((size_t)(l * 4 + (w >> 1)) * 64 + 32 * (w & 1) + ql) * 64 + 8 * g2;
#pragma unroll
      for (int kc = 0; kc < 4; ++kc) af[kc] = *(const bf16x8*)(ap + 16 * kc); }
    {
        unsigned wd[12];
#pragma unroll
        for (int it = 0; it < 12; ++it) { const int i = F.tid + it * 512, rr = i >> 7, cp = i & 127, tl = tloc - 8 + rr;
            wd[it] = 0u; if (tl >= 0 && tl < L) wd[it] = *(const unsigned*)(ZA + (size_t)(seq0 + tl) * 256 + 2 * cp); }
#pragma unroll
        for (int it = 0; it < 12; ++it) { const int i = F.tid + it * 512, rr = i >> 7, cp = i & 127;
            A[rr * 256 + 2 * cp] = __builtin_bit_cast(float, wd[it] << 16); A[rr * 256 + 2 * cp + 1] = __builtin_bit_cast(float, wd[it] & 0xffff0000u); }
    }
    __syncthreads();
    {
        const int ch = F.tid & 255, thh = F.tid >> 8, gi = ch >> 6;
        float a[31];
#pragma unroll
        for (int i = 0; i < 31; ++i) a[i] = A[(16 * thh + i) * 256 + ch];
#define POOL_WIN(HALF) do { _Pragma("unroll") for (int t = 0; t < 16; ++t) { float sm = 0.f; _Pragma("unroll") for (int j = -HALF; j < HALF; ++j) sm += a[8 + t + j]; \
            const int tl = tloc + 16 * thh + t; const int lo = max(tl - HALF, 0), hi = min(tl + HALF, L); \
            P[(16 * thh + t) * 260 + ch] = sm * __builtin_amdgcn_rcpf((float)(hi - lo)) - a[8 + t]; } } while (0)
        if (gi == 0) POOL_WIN(1); else if (gi == 1) POOL_WIN(2); else if (gi == 2) POOL_WIN(4); else POOL_WIN(8);
#undef POOL_WIN
    }
    __syncthreads();
    f32x16 Dm;
#pragma unroll
    for (int i = 0; i < 16; ++i) Dm[i] = 0.f;
    { const LAS float* pp = P + ql * 260 + (w >> 1) * 64 + 8 * g2;
#pragma unroll
      for (int kc = 0; kc < 4; ++kc) {
          const f32x4 x0 = *(const LAS f32x4*)(pp + 16 * kc), x1 = *(const LAS f32x4*)(pp + 16 * kc + 4);
          u32x4 wd; wd.x = pk2(x0[0], x0[1]); wd.y = pk2(x0[2], x0[3]); wd.z = pk2(x1[0], x1[1]); wd.w = pk2(x1[2], x1[3]);
          Dm = __builtin_amdgcn_mfma_f32_32x32x16_bf16(af[kc], __builtin_bit_cast(bf16x8, wd), Dm, 0, 0, 0);
      } }
    float ss = 0.f;
#pragma unroll
    for (int i = 0; i < 4; ++i) { const f32x4 ps = *(const f32x4*)(p.pool_scale + l * 256 + 32 * w + 8 * i + 4 * g2);
#pragma unroll
        for (int j = 0; j < 4; ++j) { Dm[4 * i + j] *= ps[j]; ss += Dm[4 * i + j] * Dm[4 * i + j]; } }
    ss = half_sum(ss);
    if (g2 == 0) part[w * 32 + ql] = ss;
    __syncthreads();
    float tot = 0.f;
#pragma unroll
    for (int w8 = 0; w8 < 8; ++w8) tot += part[w8 * 32 + ql];
    const float rstd = __builtin_amdgcn_rsqf(tot * (1.0f / 256.0f) + EPS);
#pragma unroll
    for (int i = 0; i < 4; ++i) { const int oc = 32 * w + 8 * i + 4 * g2; const f32x4 gv = *(const f32x4*)(ong + oc);
        u32x2 wv; wv.x = pk2(Dm[4 * i] * rstd * gv[0], Dm[4 * i + 1] * rstd * gv[1]); wv.y = pk2(Dm[4 * i + 2] * rstd * gv[2], Dm[4 * i + 3] * rstd * gv[3]);
        *(u32x2*)(OB + (size_t)(row0 + ql) * D + oc) = wv; }
    __syncthreads();
}

__device__ __forceinline__ void chunk_unit(const Params& p, Frame& F, int l, int u, const bf16_t* UB, const bf16_t* VGT, const bf16_t* SW, bf16_t* OB, const float* ong) {
    const int lane = F.lane, g = lane >> 5, ql = lane & 31;
    const int row0 = u * 128, w = F.wave, tb = w & 3, chh = w >> 2;
    const int tok = row0 + 32 * tb + ql;
    LAS float* part = (LAS float*)F.lds;
    float outv[2][2][16]; float ss = 0.f;
#pragma unroll
    for (int gs = 0; gs < 2; ++gs) {
        const int gi = 2 * chh + gs;
        bf16x8 bw[8];
        const bf16_t* wp = SW + ((size_t)(l * 4 + gi) * 128 + 32 * tb + ql) * 128 + 8 * g;
#pragma unroll
        for (int kc = 0; kc < 8; ++kc) bw[kc] = *(const bf16x8*)(wp + 16 * kc);
        const float bsv = p.sg_b[(size_t)(l * 4 + gi) * 128 + 32 * tb + ql];
#pragma unroll
        for (int cb = 0; cb < 2; ++cb) {
            const int ch0 = 64 * gi + 32 * cb;
            const bf16_t* ap = VGT + ((size_t)(u * 8 + 2 * gi + cb) * 8) * 512 + ql * 16 + 8 * g;
            s16x4 uv[4];
#pragma unroll
            for (int i = 0; i < 4; ++i) uv[i] = *(const s16x4*)(UB + (size_t)tok * 256 + ch0 + 8 * i + 4 * g);
            f32x16 Dm;
#pragma unroll
            for (int i = 0; i < 16; ++i) Dm[i] = 0.f;
#pragma unroll
            for (int kc = 0; kc < 8; ++kc) { const bf16x8 af = *(const bf16x8*)(ap + 512 * kc); Dm = __builtin_amdgcn_mfma_f32_32x32x16_bf16(af, bw[kc], Dm, 0, 0, 0); }
#pragma unroll
            for (int i = 0; i < 4; ++i)
#pragma unroll
                for (int j = 0; j < 4; ++j) { const float o = bf2f((unsigned short)uv[i][j]) * (Dm[4 * i + j] + bsv); outv[gs][cb][4 * i + j] = o; ss += o * o; }
        }
    }
    ss = half_sum(ss);
    if (g == 0) part[chh * 128 + 32 * tb + ql] = ss;
    __syncthreads();
    const float tot = part[32 * tb + ql] + part[128 + 32 * tb + ql];
    const float rstd = __builtin_amdgcn_rsqf(tot * (1.0f / 256.0f) + EPS);
#pragma unroll
    for (int gs = 0; gs < 2; ++gs)
#pragma unroll
        for (int cb = 0; cb < 2; ++cb)
#pragma unroll
            for (int i = 0; i < 4; ++i) {
                const int ch = 64 * (2 * chh + gs) + 32 * cb + 8 * i + 4 * g;
                const f32x4 gv = *(const f32x4*)(ong + 768 + ch);
                u32x2 wv; wv.x = pk2(outv[gs][cb][4 * i] * rstd * gv[0], outv[gs][cb][4 * i + 1] * rstd * gv[1]); wv.y = pk2(outv[gs][cb][4 * i + 2] * rstd * gv[2], outv[gs][cb][4 * i + 3] * rstd * gv[3]);
                *(u32x2*)(OB + (size_t)tok * D + 768 + ch) = wv;
            }
    __syncthreads();
}

__device__ __forceinline__ void phase_mix(const Params& p, Frame& F, int l) {
    const int lane = F.lane, h = F.wave, g = lane >> 5, ql = lane & 31;
    const int vb = (F.G % 8 == 0) ? (F.bid % 8) * (F.G / 8) + F.bid / 8 : F.bid;
    {
    const bf16_t* QB = (const bf16_t*)(p.ws + WS_Q); const bf16_t* KB = (const bf16_t*)(p.ws + WS_K); const bf16_t* VT = (const bf16_t*)(p.ws + WS_VT);
    const bf16_t* CK = (const bf16_t*)(p.ws + WS_CK); const bf16_t* CVT = (const bf16_t*)(p.ws + WS_CVT);
    bf16_t* OB = (bf16_t*)(p.ws + WS_OB);
    const float* ong = p.out_norm_g + l * 1024;
    for (int u = vb; u < 256; u += F.G) {
        const int b = u >> 5, r = (u >> 1) & 15, qh = u & 1;
        const int q0 = MCTX + b * 1024 + r * 64 + qh * 32;
        LAS float* rpbL = (LAS float*)(F.lds + F.wave * 7680);
        for (int i = lane; i < 15 * 128; i += 64) rpbL[i] = 0.f;
        { float tv[8];
#pragma unroll
          for (int k = 0; k < 8; ++k) { const int i = lane + 64 * k; tv[k] = i < 465 ? p.na_rpb[((size_t)l * 8 + h) * 465 + i] : 0.f; }
#pragma unroll
          for (int k = 0; k < 8; ++k) { const int i = lane + 64 * k; if (i < 465) rpbL[(i / 31) * 128 + 48 + (i % 31)] = tv[k] * LOG2E; } }
        bf16x8 qf[4];
#pragma unroll
        for (int c = 0; c < 4; ++c) qf[c] = *(const bf16x8*)(QB + ((size_t)h * M + q0 + ql) * 64 + 16 * c + 8 * g);
        AttnState st;
#pragma unroll
        for (int i = 0; i < 16; ++i) { st.O0[i] = 0.f; st.O1[i] = 0.f; }
        st.m = -1e30f; st.l = 0.f;
        const bf16_t* ck = CK + (size_t)((b * 2 + l) * 8 + h) * 256 * 64; const bf16_t* cvt = CVT + (size_t)((b * 2 + l) * 8 + h) * 64 * 256;
        attn_run<false>(st, qf, ck, cvt, 8, lane, rpbL, 0, 0, 0, 0);
        const int start = min(max(r - 4, 0), 8);
        const int qc = qh * 32 + ql, cs = min(max(qc - 8, 0), 48);
        const size_t toff = ((size_t)h * M + MCTX + b * 1024 + start * 64) * 64;
        attn_run<true>(st, qf, KB + toff, VT + toff, 16, lane, rpbL, r, start, qc, cs);
        attn_finish(F, st, q0, h, ong + 256, OB);
    }
    for (int u = vb; u < 256; u += F.G) {
        const int b = u >> 3, qb = u & 7, q0 = b * 256 + qb * 32;
        bf16x8 qf[4];
#pragma unroll
        for (int c = 0; c < 4; ++c) qf[c] = *(const bf16x8*)(QB + ((size_t)h * M + q0 + ql) * 64 + 16 * c + 8 * g);
        AttnState st;
#pragma unroll
        for (int i = 0; i < 16; ++i) { st.O0[i] = 0.f; st.O1[i] = 0.f; }
        st.m = -1e30f; st.l = 0.f;
        const size_t toff = ((size_t)h * M + b * 256) * 64;
        attn_run<false>(st, qf, KB + toff, VT + toff, 8, lane, (const LAS float*)F.lds, 0, 0, 0, 0);
        attn_finish(F, st, q0, h, ong + 256, OB);
    }
    }
    const bf16_t* ZA = (const bf16_t*)(p.ws + WS_ZA); const bf16_t* UB = (const bf16_t*)(p.ws + WS_UT); const bf16_t* VGT = (const bf16_t*)(p.ws + WS_VGT);
    const bf16_t* SW = (const bf16_t*)(p.ws + WS_SW); const bf16_t* PWT = (const bf16_t*)(p.ws + WS_PW);
    bf16_t* OB = (bf16_t*)(p.ws + WS_OB);
    const float* ong = p.out_norm_g + l * 1024;
    if (F.G == 256) {
        if (F.bid < 128) { chunk_unit(p, F, l, F.bid, UB, VGT, SW, OB, ong); pool_unit(p, F, l, F.bid, ZA, PWT, OB, ong); }
        else { for (int i = 0; i < 3; ++i) pool_unit(p, F, l, 128 + (F.bid - 128) * 3 + i, ZA, PWT, OB, ong); }
    } else {
        for (int u = F.bid; u < 128; u += F.G) chunk_unit(p, F, l, u, UB, VGT, SW, OB, ong);
        for (int u = F.bid; u < 512; u += F.G) pool_unit(p, F, l, u, ZA, PWT, OB, ong);
    }
}

#define XB_TMO      128
#define XB_XCNT(j)  (256  + 64 * (j))
#define XB_XSUB(j)  (1280 + 64 * (j))
#define XB_XGEN(j)  (2304 + 64 * (j))
#define XB_TOP      3328
#define XB_TOPGEN   3392
#define XCD_BAR_WORDS 3456
#define XB_SPIN_CAP (1u << 18)
__device__ __forceinline__ unsigned xb_ld(unsigned* p)              { return __hip_atomic_load(p, __ATOMIC_RELAXED, __HIP_MEMORY_SCOPE_AGENT); }
__device__ __forceinline__ unsigned xb_add(unsigned* p, unsigned v) { return __hip_atomic_fetch_add(p, v, __ATOMIC_RELAXED, __HIP_MEMORY_SCOPE_AGENT); }
__device__ __forceinline__ unsigned xb_xcc_id() { return (unsigned)__builtin_amdgcn_s_getreg((3 << 11) | 20) & 0xFu; }
#define XB_SPIN(cond, bar) do { unsigned _sp = 0; while (cond) { __builtin_amdgcn_s_sleep(1); \
    if ((++_sp & 255u) == 0u) { if (xb_ld(&(bar)[XB_TMO])) break; if (_sp > XB_SPIN_CAP) { atomicAdd(&(bar)[XB_TMO], 1u); break; } } } } while (0)
struct XcdBarrier { unsigned* bar; unsigned x; volatile LAS unsigned* st; };
__device__ __forceinline__ XcdBarrier xcd_barrier_post(unsigned* bar, volatile LAS unsigned* st) {
    XcdBarrier b; b.bar = bar; b.x = xb_xcc_id(); b.st = st;
    if (threadIdx.x == 0) (void)xb_add(&bar[XB_XCNT(b.x)], 1u);
    return b;
}
__device__ __forceinline__ void xcd_barrier_complete(unsigned* bar, unsigned x, unsigned& nloc, unsigned& nx) {
    const unsigned G = gridDim.x * gridDim.y * gridDim.z;
    unsigned sum, cnt, mine, sp = 0u;
    for (;;) {
        sum = 0u; cnt = 0u; mine = 0u;
#pragma unroll
        for (unsigned j = 0; j < 16; ++j) { const unsigned c = xb_ld(&bar[XB_XCNT(j)]); sum += c; cnt += (c > 0u) ? 1u : 0u; mine = (j == x) ? c : mine; }
        if (sum == G) break;
        __builtin_amdgcn_s_sleep(1);
        if ((++sp & 255u) == 0u) { if (xb_ld(&bar[XB_TMO])) break; if (sp > XB_SPIN_CAP) { atomicAdd(&bar[XB_TMO], 1u); break; } }
    }
    nloc = mine > 0u ? mine : 1u; nx = cnt > 0u ? cnt : 1u;
}
__device__ __forceinline__ void xcd_barrier(const XcdBarrier& b) {
    asm volatile("s_waitcnt vmcnt(0)" ::: "memory");
    __syncthreads();
    if (threadIdx.x == 0) {
        unsigned* bar = b.bar;
        __builtin_amdgcn_s_waitcnt(0);
        unsigned nloc = b.st[0], nx = b.st[1];
        if (nloc == 0u) { xcd_barrier_complete(bar, b.x, nloc, nx); b.st[0] = nloc; b.st[1] = nx; }
        const unsigned old = xb_add(&bar[XB_XSUB(b.x)], 1u);
        const unsigned gen = old / nloc;
        if (old + 1u == (gen + 1u) * nloc) {
            __builtin_amdgcn_fence(__ATOMIC_RELEASE, "agent");
            asm volatile("s_waitcnt vmcnt(0)" ::: "memory");
            const unsigned og = xb_add(&bar[XB_TOP], 1u);
            const unsigned tg = og / nx;
            if (og + 1u == (tg + 1u) * nx) xb_add(&bar[XB_TOPGEN], 1u);
            else XB_SPIN(xb_ld(&bar[XB_TOPGEN]) == tg, bar);
            __builtin_amdgcn_fence(__ATOMIC_ACQUIRE, "agent");
            xb_add(&bar[XB_XGEN(b.x)], 1u);
            asm volatile("s_waitcnt vmcnt(0)" ::: "memory");
        } else {
            XB_SPIN(xb_ld(&bar[XB_XGEN(b.x)]) == gen, bar);
            __builtin_amdgcn_fence(__ATOMIC_ACQUIRE, "agent");
            asm volatile("s_waitcnt vmcnt(0)" ::: "memory");
        }
    }
    __syncthreads();
}

constexpr int LDS_MISC = 135168;
constexpr int LDS_BYTES = LDS_MISC + 64;
constexpr int NPHASE = 16;

__global__ void __launch_bounds__(512, 2) fwd_megakernel(Params p_in) {
    extern __shared__ __attribute__((aligned(16))) unsigned char lds_raw[];
    cg::grid_group grid = cg::this_grid();
    { volatile LAS unsigned* st0 = (volatile LAS unsigned*)((LAS unsigned char*)lds_raw + LDS_MISC); if (threadIdx.x < 16) st0[threadIdx.x] = 0u; }
    __syncthreads();
    (void)xcd_barrier_post((unsigned*)(p_in.ws + WS_CTL), (volatile LAS unsigned*)((LAS unsigned char*)lds_raw + LDS_MISC));
#define XBAR() do { XcdBarrier xb_; xb_.bar = (unsigned*)(p_in.ws + WS_CTL); xb_.x = xb_xcc_id(); xb_.st = (volatile LAS unsigned*)((LAS unsigned char*)lds_raw + LDS_MISC); xcd_barrier(xb_); } while (0)
    if (p_in.ph_lo < 0) grid.sync();
    int rep_ = 0;
    int wave_s = __builtin_amdgcn_readfirstlane((int)threadIdx.x >> 6);
    KargPtr kp4 = (KargPtr)__builtin_amdgcn_kernarg_segment_ptr();
    const int ph_hi_ = p_in.ph_hi;
#pragma nounroll
    for (int ph = p_in.ph_lo; ph < ph_hi_; ++ph) {
        asm volatile("" : "+s"(wave_s));
        int lane_ = (int)__builtin_amdgcn_mbcnt_hi(~0u, __builtin_amdgcn_mbcnt_lo(~0u, 0u)); asm volatile("" : "+v"(lane_));
        int tid_ = wave_s * 64 + lane_;
        asm volatile("" : "+s"(kp4));
#if defined(__HIP_DEVICE_COMPILE__)
        const Params p = *kp4;
#else
        const Params p = p_in;
#endif
        int bid_ = blockIdx.x; asm volatile("" : "+s"(bid_));
        unsigned lds0 = 0; asm volatile("" : "+s"(lds0));
        Frame F;
        F.lds = (LAS unsigned char*)lds_raw + lds0;
        F.tid = tid_; F.lane = F.tid & 63; F.wave = __builtin_amdgcn_readfirstlane(F.tid >> 6);
        F.G = gridDim.x; F.bid = bid_;
        const float* MOD = (const float*)(p.ws + WS_MOD);
        bf16_t* H = (bf16_t*)(p.ws + WS_H); bf16_t* ACT = (bf16_t*)(p.ws + WS_ACT); bf16_t* OB = (bf16_t*)(p.ws + WS_OB);
        float* X = p.out;
        if (ph == 0) {
#if !defined(MASK) || ((MASK>>0)&1)
            phase_prologue(p, F);
#endif
        } else {
            const int l = ph == 1 ? 0 : (ph - 2) / 7, k = ph == 1 ? -1 : (ph - 2) % 7;
            const float* modl = MOD + (size_t)l * 81 * 1024;
            unsigned char* wl = p.ws + WS_W + (size_t)l * W_LAYER;
            if (k == 3) {
#if !defined(MASK) || ((MASK>>5)&1)
                phase_mix(p, F, l);
#endif
            } else {
#if !defined(MASK) || ((MASK>>2)&1)
                EpiAll E; E.c0 = ECtx{kp4, l, k, F.lds + 131072};
                pg8::Gemm g; int N;
                if (k == -1) { g = pg8::Gemm{(const bf16_t*)(p.ws + WS_SHB), (const bf16_t*)(p.ws + WS_W), 256, NB, D}; N = NB; }
                else if (k == 0 || k == 5) { g = pg8::Gemm{H, (const bf16_t*)(wl + (k == 0 ? W_GU0 : W_GU1)), M, NGU, D}; N = NGU; }
                else if (k == 4) { g = pg8::Gemm{OB, (const bf16_t*)(wl + W_OUT), M, D, D}; N = D; }
                else if (k == 2) { g = pg8::Gemm{H, (const bf16_t*)(wl + W_IN), M, NIN, D}; N = NIN; }
                else { const int f = k == 1 ? 0 : 1; g = pg8::Gemm{ACT, (const bf16_t*)(wl + W_D + f * W_D_SZ), M, D, FF}; N = D; }
                pg8::StaticOrder S;
                const bool full = F.G == 256;
                if (k == -1) {
                    const int lb = F.bid < 53 ? 0 : 1;
                    g.A = (const bf16_t*)(p.ws + WS_SHB) + (size_t)lb * 256 * 1024; g.Bt = (const bf16_t*)(p.ws + WS_W + (size_t)lb * W_LAYER); E.c0.l = lb;
                    S.init(256, NB, 53, F.bid % 53);
                    if (F.bid >= (full ? 53 : 106)) S.nwg = 0;
                } else {
                    S.init(M, N, F.G, F.bid);
                    if (full && l == 0 && k == 5 && F.bid >= 203) { S.exi = 5; S.expm = -167; S.expn = 48 + (F.bid - 203); }
                }
                pg8::gemm_phase<EpiAll>(F.lds, F.tid, g, S, E);
                if (k == -1) phase_norm0(p, F);
                if (full && l == 0) {
                    if (k == 0 && F.bid >= 128) convert_items(p, F, 0, CV_NA, CV_LAYER, (F.bid - 128) * 8 + F.wave, 128 * 8);
                    if (k == 2 && F.bid >= 64) convert_items(p, F, 1, 0, CV_NA, (F.bid - 64) * 8 + F.wave, 192 * 8);
                    if (k == 5 && F.bid >= 128 && F.bid < 203) convert_items(p, F, 1, CV_NA, CV_LAYER, (F.bid - 128) * 8 + F.wave, 75 * 8);
                }
#endif
            }
        }
#if PROBE_REP
        { const int kind_ = ph < 2 ? ph : 2 + (ph - 2) % 7;
          if (((PROBE_REP >> kind_) & 1) && rep_ == 0) { rep_ = 1; XBAR(); --ph; continue; }
          rep_ = 0; }
#endif
        if (ph + 1 < ph_hi_) XBAR();
    }
    for (int i_ = 0; i_ < PROBE_SYNC; ++i_) XBAR();
}

extern "C" void kernel_launch(void* const* d_in, const int* in_sizes, int n_in, void* d_out, int out_size, void* d_ws, size_t ws_size, hipStream_t stream) {
    static int grid_blocks = 0;
    if (!grid_blocks) {
        int dev = 0, cus = 0, per_cu = 0;
        hipGetDevice(&dev);
        hipDeviceGetAttribute(&cus, hipDeviceAttributeMultiprocessorCount, dev);
        hipFuncSetAttribute((const void*)fwd_megakernel, hipFuncAttributeMaxDynamicSharedMemorySize, LDS_BYTES);
        hipOccupancyMaxActiveBlocksPerMultiprocessor(&per_cu, (const void*)fwd_megakernel, 512, LDS_BYTES);
        if (per_cu < 1) { fprintf(stderr, "kernel_launch: occupancy query reports %d blocks per CU\n", per_cu); per_cu = 1; }
        grid_blocks = cus;
        (void)hipGetLastError();
    }
    Params p{};
    const float** pp = (const float**)&p;
    for (int i = 0; i < 23; ++i) pp[i] = (const float*)d_in[i];
    p.out = (float*)d_out; p.ws = (unsigned char*)d_ws;
    p.ph_lo = 0; p.ph_hi = NPHASE;
    (void)hipMemsetAsync((unsigned char*)d_ws + WS_CTL, 0, CTL_BYTES, stream);
    void* args[] = {&p};
    hipError_t e = hipLaunchCooperativeKernel((const void*)fwd_megakernel, dim3(grid_blocks), dim3(512), args, LDS_BYTES, stream);
    if (e != hipSuccess) fprintf(stderr, "cooperative launch failed: %s (grid %d)\n", hipGetErrorString(e), grid_blocks);
}
```

```cpp
#include <hip/hip_runtime.h>
#include <hip/hip_cooperative_groups.h>
#include <cstdio>
#include <cstdint>
namespace cg = cooperative_groups;

#define PROBE_REP 0
#define PROBE_SYNC 0
#define PROBE_MIX 0

#define LAS __attribute__((address_space(3)))
typedef unsigned short bf16_t;
typedef short bf16x8 __attribute__((ext_vector_type(8)));
typedef short s16x4 __attribute__((ext_vector_type(4)));
typedef float f32x4 __attribute__((ext_vector_type(4)));
typedef float f32x2 __attribute__((ext_vector_type(2)));
typedef float f32x16 __attribute__((ext_vector_type(16)));
typedef unsigned u32x4 __attribute__((ext_vector_type(4)));
typedef unsigned u32x2 __attribute__((ext_vector_type(2)));

constexpr int M = 16384, MCTX = 8192, D = 1024, FF = 2816, NGU = 2 * FF, NIN = 2304, NMOD = 9;
constexpr int NK_OFF = 16777216, NV_OFF = 25165824;
constexpr float EPS = 1e-6f;
constexpr float LOG2E = 1.4426950408889634f;

constexpr size_t MiB = 1u << 20;
constexpr size_t WS_MOD = 0;
constexpr size_t WS_CTL = 1 * MiB + 512 * 1024, CTL_BYTES = 16384;
constexpr size_t WS_PW = 1 * MiB + 256 * 1024;
constexpr size_t WS_SW = 1 * MiB;
constexpr size_t WS_CK = 2 * MiB;
constexpr size_t WS_CVT = 6 * MiB;
constexpr size_t WS_SSP = 10 * MiB;
constexpr size_t WS_BIAS = 11 * MiB;
constexpr size_t WS_SHB = 12 * MiB;
constexpr int NB = 13568;
constexpr size_t WS_W = 16 * MiB;
constexpr size_t W_GU_SZ = (size_t)NGU * D * 2, W_IN_SZ = (size_t)NIN * D * 2, W_D_SZ = (size_t)D * FF * 2, W_OUT_SZ = (size_t)D * D * 2;
constexpr size_t W_GU0 = 0, W_IN = W_GU_SZ, W_GU1 = W_IN + W_IN_SZ, W_D = W_GU1 + W_GU_SZ, W_OUT = W_D + 2 * W_D_SZ;
constexpr size_t W_LAYER = W_OUT + W_OUT_SZ;
constexpr size_t WS_H = 96 * MiB;
constexpr size_t WS_ACT = 128 * MiB;
constexpr size_t WS_ZA = 128 * MiB;
constexpr size_t WS_UT = 136 * MiB;
constexpr size_t WS_VGT = 144 * MiB;
constexpr size_t WS_Q = 152 * MiB;
constexpr size_t WS_K = 168 * MiB;
constexpr size_t WS_VT = 184 * MiB;
constexpr size_t WS_OB = 200 * MiB;
constexpr size_t WS_XB = 232 * MiB;
static_assert(WS_W + 2 * W_LAYER <= WS_H, "weights fit");

struct Params {
    const float *x_prompt, *x_sample, *cache_k, *cache_v, *c, *c_ctx, *ada_w, *ada_b, *norm_g;
    const float *w_gate, *w_up, *w_down, *w_in, *pool_w, *pool_scale, *q_norm_g, *k_norm_g, *na_rpb;
    const float *sg_vnorm_g, *sg_w, *sg_b, *out_norm_g, *w_out;
    float* out; unsigned char* ws;
    int ph_lo, ph_hi;
};

typedef __bf16 hbf16x2 __attribute__((ext_vector_type(2)));
__device__ __forceinline__ unsigned pk2(float lo, float hi) { const f32x2 v = {lo, hi}; const hbf16x2 b = __builtin_convertvector(v, hbf16x2); return __builtin_bit_cast(unsigned, b); }
__device__ __forceinline__ unsigned f2bf(float f) { return pk2(f, 0.f) & 0xffffu; }
typedef const __attribute__((address_space(4))) Params* KargPtr;
struct ECtx { KargPtr kp; int l, k; LAS unsigned char* lds_epi_; };
__device__ __forceinline__ float bf2f(unsigned short b) { return __builtin_bit_cast(float, (unsigned)b << 16); }
__device__ __forceinline__ float wave_sum(float v) {
#pragma unroll
    for (int o = 1; o < 64; o <<= 1) v += __shfl_xor(v, o);
    return v;
}
__device__ __forceinline__ float fast_sigmoid(float x) { return __builtin_amdgcn_rcpf(1.0f + __builtin_amdgcn_exp2f(-x * LOG2E)); }
__device__ __forceinline__ float silu_f(float x) { return x * fast_sigmoid(x); }
__device__ __forceinline__ float gelu_tanh(float x) { const float y = 0.7978845608028654f * (x + 0.044715f * x * x * x); return x * fast_sigmoid(2.0f * y); }
__device__ __forceinline__ int kind_of_row(int row) { return row < MCTX ? 0 : 1 + ((row - MCTX) >> 10); }

namespace pg8 {
constexpr int BM = 256, BK = 64, HALF = 128, HTB = HALF * BK * 2, STAGE_BYTES = 8 * HTB, NXCD = 8, WGM = 8;
__host__ __device__ __forceinline__ int lds_byte(int r, int c) { const int st = (r >> 4) * 2 + (c >> 5), rr = r & 15, cc = c & 31, ob = rr * 64 + cc * 2; return st * 1024 + (ob ^ (((ob >> 9) & 1) << 5)); }
__host__ __device__ __forceinline__ void stage_rc(int b, int& R, int& C) { const int st = b / 1024, sb = b % 1024, swz = sb ^ (((sb >> 9) & 1) << 5); R = (st >> 1) * 16 + swz / 64; C = (st & 1) * 32 + (swz % 64) / 2; }
struct Unit { int pm, pn; };
struct Gemm { const bf16_t* A; const bf16_t* Bt; int M, N, K; };
struct StaticOrder {
    int nM, nN, nwg, G, c; int exi, expm, expn;
    __device__ void init(int M_, int N_, int G_, int c_) { nM = M_ / BM; nN = N_ / BM; nwg = nM * nN; G = G_; c = c_; exi = -1; expm = 0; expn = 0; }
    __device__ bool next(int i, Unit& u) const {
        const long L = (long)i * G + c; if (L >= nwg) { if (i == exi) { u.pm = expm; u.pn = expn; return true; } return false; }
        int wgid = (int)L; { const int q = nwg / NXCD, r = nwg % NXCD, xcd = wgid % NXCD, off = wgid / NXCD; wgid = (xcd < r ? xcd * (q + 1) : r * (q + 1) + (xcd - r) * q) + off; }
        const int nig = WGM * nN, gid = wgid / nig, fm = gid * WGM, gsz = (nM - fm) < WGM ? (nM - fm) : WGM;
        u.pm = fm + ((wgid % nig) % gsz); u.pn = (wgid % nig) / gsz;
        if (nN == 9) u.pn = u.pn == 8 ? 0 : u.pn + 1;
        return true;
    }
};
template <class Epi>
__device__ __forceinline__ void gemm_phase(LAS unsigned char* lds, const int tid, const Gemm g, const StaticOrder& S, const Epi& E) {
    const int wid = __builtin_amdgcn_readfirstlane(tid >> 6), lane = tid & 63, wr = wid >> 2, wc = wid & 3, fr = lane & 15, fq = lane >> 4;
    const int K = g.K, nt = K / BK;
    unsigned voffA[2];
#pragma unroll
    for (int i = 0; i < 2; ++i) { int R, C; stage_rc(tid * 16 + i * 8192, R, C); voffA[i] = (unsigned)(R * K + C) * 2u; }
    const size_t kstep = (size_t)(BK * 2);
    const size_t hstep = (size_t)HALF * K * 2;
    const size_t tstep = 2 * hstep;
    const unsigned ldsw = (unsigned)wid * 1024u;
    const int aoff = lds_byte(wr * 64 + fr, fq * 8), boff = lds_byte(wc * 32 + fr, fq * 8);
#define PG8_SA(b, h) (((b) * 2 + (h)) * HTB)
#define PG8_SB(b, h) ((4 + (b) * 2 + (h)) * HTB)
#define PG8_STAGE(bufoff, gbase) do { _Pragma("unroll") for (int _i = 0; _i < 2; ++_i) \
        __builtin_amdgcn_global_load_lds((const unsigned*)((const char*)(gbase) + voffA[_i]), (LAS unsigned*)(lds + (bufoff) + ldsw + _i * 8192), 16, 0, 0); } while (0)
#define PG8_LDA(dst, b, h) do { _Pragma("unroll") for (int m = 0; m < 4; ++m) _Pragma("unroll") for (int k = 0; k < 2; ++k) dst[m][k] = *(const LAS bf16x8*)(lds + PG8_SA(b, h) + aoff + m * 2048 + k * 1024); } while (0)
#define PG8_LDB(dst, b, h) do { _Pragma("unroll") for (int n = 0; n < 2; ++n) _Pragma("unroll") for (int k = 0; k < 2; ++k) dst[n][k] = *(const LAS bf16x8*)(lds + PG8_SB(b, h) + boff + n * 2048 + k * 1024); } while (0)
#define PG8_MMA(ai, bj, At, Bt) do { __builtin_amdgcn_s_setprio(1); _Pragma("unroll") for (int m = 0; m < 4; ++m) _Pragma("unroll") for (int n = 0; n < 2; ++n) _Pragma("unroll") for (int k = 0; k < 2; ++k) \
        acc[ai][bj][m][n] = __builtin_amdgcn_mfma_f32_16x16x32_bf16(Bt[n][k], At[m][k], acc[ai][bj][m][n], 0, 0, 0); __builtin_amdgcn_s_setprio(0); } while (0)
#define PG8_WAIT_V(n) asm volatile("s_waitcnt vmcnt(" #n ")" ::: "memory")
#define PG8_WAIT_L(n) asm volatile("s_waitcnt lgkmcnt(" #n ")" ::: "memory")
#define PG8_BAR __builtin_amdgcn_s_barrier()
#define PG8_SCHED __builtin_amdgcn_sched_barrier(0)
    Unit cur, nxt; int ui = 0;
    if (!S.next(0, cur)) return;
    f32x4 acc[2][2][4][2];
#pragma unroll
    for (int a = 0; a < 2; ++a)
#pragma unroll
        for (int b = 0; b < 2; ++b)
#pragma unroll
            for (int m = 0; m < 4; ++m)
#pragma unroll
                for (int n = 0; n < 2; ++n) acc[a][b][m][n] = (f32x4){0.f, 0.f, 0.f, 0.f};
    bf16x8 At[4][2], B0[2][2], B1[2][2];
    const char* cA = (const char*)g.A + (size_t)cur.pm * tstep; const char* cB = (const char*)g.Bt + (size_t)cur.pn * tstep;
    PG8_STAGE(PG8_SB(0, 0), cB); PG8_STAGE(PG8_SB(0, 1), cB + hstep); PG8_STAGE(PG8_SA(0, 0), cA); PG8_STAGE(PG8_SA(0, 1), cA + hstep);
    if (wr == 1) PG8_BAR;
    PG8_WAIT_V(2); PG8_BAR;
    PG8_STAGE(PG8_SB(1, 0), cB + kstep); PG8_STAGE(PG8_SA(1, 0), cA + kstep); PG8_STAGE(PG8_SB(1, 1), cB + hstep + kstep);
    PG8_WAIT_V(6); PG8_BAR;
    for (;;) {
        const bool has_next = S.next(ui + 1, nxt);
        const char* nA = has_next ? (const char*)g.A + (size_t)nxt.pm * tstep : cA; const char* nB = has_next ? (const char*)g.Bt + (size_t)nxt.pn * tstep : cB;
        for (int t = 0; t < nt; t += 2) {
            const bool last = (t == nt - 2);
            const char* a1 = cA + (size_t)(t + 1) * kstep;
            const char* a2 = last ? nA : cA + (size_t)(t + 2) * kstep; const char* b2 = last ? nB : cB + (size_t)(t + 2) * kstep;
            const char* a3 = a2 + kstep; const char* b3 = b2 + kstep;
            PG8_LDB(B0, 0, 0); PG8_LDB(B1, 0, 1); PG8_SCHED; PG8_LDA(At, 0, 0); PG8_STAGE(PG8_SA(1, 1), a1 + hstep);
            PG8_WAIT_V(8); PG8_WAIT_L(0); PG8_BAR; PG8_MMA(0, 0, At, B0); PG8_MMA(0, 1, At, B1); PG8_BAR; PG8_SCHED;
            PG8_LDA(At, 0, 1); PG8_STAGE(PG8_SB(0, 0), b2); PG8_STAGE(PG8_SB(0, 1), b2 + hstep); PG8_STAGE(PG8_SA(0, 0), a2);
            PG8_WAIT_V(8); PG8_WAIT_L(0); PG8_BAR; PG8_MMA(1, 0, At, B0); PG8_MMA(1, 1, At, B1); PG8_BAR; PG8_SCHED;
            PG8_LDB(B0, 1, 0); PG8_LDB(B1, 1, 1); PG8_SCHED; PG8_LDA(At, 1, 0); PG8_STAGE(PG8_SA(0, 1), a2 + hstep);
            PG8_WAIT_V(8); PG8_WAIT_L(0); PG8_BAR; PG8_MMA(0, 0, At, B0); PG8_MMA(0, 1, At, B1); PG8_BAR; PG8_SCHED;
            PG8_LDA(At, 1, 1); PG8_STAGE(PG8_SB(1, 0), b3); PG8_STAGE(PG8_SB(1, 1), b3 + hstep); PG8_STAGE(PG8_SA(1, 0), a3);
            PG8_WAIT_V(8); PG8_WAIT_L(0); PG8_BAR; PG8_MMA(1, 0, At, B0); PG8_MMA(1, 1, At, B1); PG8_BAR; PG8_SCHED;
        }
        if (wr == 0) PG8_BAR;
        E(acc, cur, wr, wc, fr, fq);
        if (!has_next) break;
#pragma unroll
        for (int a = 0; a < 2; ++a)
#pragma unroll
            for (int b = 0; b < 2; ++b)
#pragma unroll
                for (int m = 0; m < 4; ++m)
#pragma unroll
                    for (int n = 0; n < 2; ++n) acc[a][b][m][n] = (f32x4){0.f, 0.f, 0.f, 0.f};
        cur = nxt; cA = nA; cB = nB; ++ui;
        if (wr == 1) PG8_BAR;
    }
    PG8_WAIT_V(0);
    PG8_BAR;
#undef PG8_SA
#undef PG8_SB
#undef PG8_STAGE
#undef PG8_LDA
#undef PG8_LDB
#undef PG8_MMA
#undef PG8_WAIT_V
#undef PG8_WAIT_L
#undef PG8_BAR
#undef PG8_SCHED
}
}

__device__ __forceinline__ float row_rstd(const float* ssp, int row) {
    const f32x4 a = *(const f32x4*)(ssp + (size_t)row * 4);
    return __builtin_amdgcn_rsqf(((a[0] + a[1]) + (a[2] + a[3])) * (1.0f / D) + EPS);
}
__device__ __forceinline__ float rstd_of(const f32x4 a) { return __builtin_amdgcn_rsqf(((a[0] + a[1]) + (a[2] + a[3])) * (1.0f / D) + EPS); }
struct EpiSwiglu {
    ECtx c;
    __device__ __forceinline__ void operator()(const f32x4 (&acc)[2][2][4][2], const pg8::Unit& u, int wr, int wc, int fr, int fq) const {
        unsigned char* ws = c.kp->ws;
        bf16_t* act = (bf16_t*)(ws + WS_ACT); const float* ssp = (const float*)(ws + WS_SSP);
        const float* bias = (const float*)(ws + WS_BIAS) + (size_t)c.l * 9 * NB + (c.k == 5 ? 7936 : 0);
        const int kind = u.pm < 32 ? 0 : 1 + ((u.pm - 32) >> 2);
        const float* bp = bias + (size_t)kind * NB + u.pn * 256 + wc * 32 + fq * 4;
        f32x4 bg[2], bu[2];
#pragma unroll
        for (int bj = 0; bj < 2; ++bj) { bg[bj] = *(const f32x4*)(bp + bj * 128); bu[bj] = *(const f32x4*)(bp + bj * 128 + 16); }
        const float* sbase = ssp + (size_t)(u.pm * 256 + wr * 64 + fr) * 4;
        f32x4 sn = *(const f32x4*)sbase;
#pragma unroll
        for (int ai = 0; ai < 2; ++ai)
#pragma unroll
            for (int m = 0; m < 4; ++m) {
                int row = u.pm * 256 + ai * 128 + wr * 64 + m * 16 + fr; asm volatile("" : "+v"(row));
                const float rs = rstd_of(sn);
                if (ai * 4 + m < 7) sn = *(const f32x4*)(sbase + (((m + 1) >> 2) + ai) * 512 + ((m + 1) & 3) * 64);
                bf16_t* rp = act + (size_t)row * FF + u.pn * 128 + wc * 32 + fq * 8;
                u32x4 w;
                { const f32x4 gg = acc[ai][0][m][0] * rs + bg[0], uu = acc[ai][0][m][1] * rs + bu[0];
                  w.x = pk2(silu_f(gg[0]) * uu[0], silu_f(gg[1]) * uu[1]); w.y = pk2(silu_f(gg[2]) * uu[2], silu_f(gg[3]) * uu[3]); }
                { const f32x4 gg = acc[ai][1][m][0] * rs + bg[1], uu = acc[ai][1][m][1] * rs + bu[1];
                  w.z = pk2(silu_f(gg[0]) * uu[0], silu_f(gg[1]) * uu[1]); w.w = pk2(silu_f(gg[2]) * uu[2], silu_f(gg[3]) * uu[3]); }
                *(u32x4*)rp = w;
            }
    }
};
struct EpiRes {
    ECtx c;
    __device__ __forceinline__ void operator()(const f32x4 (&acc)[2][2][4][2], const pg8::Unit& u, int wr, int wc, int fr, int fq) const {
        unsigned char* ws = c.kp->ws; float* xout = c.kp->out;
        const float* MOD = (const float*)(ws + WS_MOD); const float* modl = MOD + (size_t)c.l * 81 * 1024;
        const bool from_in = c.l == 0 && c.k == 1;
        const float* xin_ctx = c.kp->x_prompt; const float* xin_lat = c.kp->x_sample;
        const int gi = c.k == 4 ? 5 : (c.k == 1 ? 2 : 8); const float coef = c.k == 4 ? 1.0f : 0.5f;
        const int nsub = c.k == 4 ? 2 : (c.k == 1 ? 1 : 0), nl = c.k == 6 ? c.l + 1 : c.l;
        const float* ng = nl < 2 ? c.kp->norm_g + (size_t)(nl * 3 + nsub) * 1024 : nullptr;
        const float* nmod = MOD + (size_t)nl * 81 * 1024; const int nsc = 3 * nsub + 1;
        bf16_t* hn = (bf16_t*)(ws + WS_H); float* ssp = (float*)(ws + WS_SSP);
        LAS float* ssl = (LAS float*)c.lds_epi_;
        const int kind = u.pm < 32 ? 0 : 1 + ((u.pm - 32) >> 2);
        const float* gv = modl + (size_t)(kind * 9 + gi) * 1024;
        const int col0 = u.pn * 256 + wc * 32 + fq * 8;
        f32x4 gt[2][2], gs[2][2];
#pragma unroll
        for (int bj = 0; bj < 2; ++bj)
#pragma unroll
            for (int n = 0; n < 2; ++n) {
                gt[bj][n] = *(const f32x4*)(gv + col0 + bj * 128 + n * 4) * coef;
                if (ng) gs[bj][n] = *(const f32x4*)(ng + col0 + bj * 128 + n * 4) * (*(const f32x4*)(nmod + (size_t)(kind * 9 + nsc) * 1024 + col0 + bj * 128 + n * 4) + 1.0f);
            }
        const float* xin = u.pm < 32 ? xin_ctx : xin_lat;
        const int rbase = (u.pm < 32 ? u.pm : u.pm - 32) * 256;
        bf16_t* xb = (bf16_t*)(ws + WS_XB);
        const bool is_last = nl >= 2;
        u32x4 xnb[2];
        if (!from_in) { const bf16_t* xp0 = xb + (size_t)(u.pm * 256 + wr * 64 + fr) * D + col0;
#pragma unroll
            for (int bj = 0; bj < 2; ++bj) xnb[bj] = *(const u32x4*)(xp0 + bj * 128); }
#pragma unroll
        for (int ai = 0; ai < 2; ++ai)
#pragma unroll
            for (int m = 0; m < 4; ++m) {
                int rl = ai * 128 + wr * 64 + m * 16 + fr; asm volatile("" : "+v"(rl));
                const float* ip = xin + (size_t)(rbase + rl) * D + col0;
                float* op = xout + (size_t)(u.pm * 256 + rl) * D + col0;
                bf16_t* hp = hn + (size_t)(u.pm * 256 + rl) * D + col0;
                bf16_t* xp = xb + (size_t)(u.pm * 256 + rl) * D + col0;
                f32x4 xc[2][2];
                if (from_in) {
#pragma unroll
                    for (int bj = 0; bj < 2; ++bj)
#pragma unroll
                        for (int n = 0; n < 2; ++n) xc[bj][n] = __builtin_nontemporal_load((const f32x4*)(ip + bj * 128 + n * 4));
                } else {
#pragma unroll
                    for (int bj = 0; bj < 2; ++bj)
#pragma unroll
                        for (int n = 0; n < 2; ++n) { const unsigned wx_ = n ? xnb[bj].z : xnb[bj].x, wy_ = n ? xnb[bj].w : xnb[bj].y;
                            xc[bj][n] = (f32x4){__builtin_bit_cast(float, wx_ << 16), __builtin_bit_cast(float, wx_ & 0xffff0000u), __builtin_bit_cast(float, wy_ << 16), __builtin_bit_cast(float, wy_ & 0xffff0000u)}; }
                    if (ai * 4 + m < 7) { const bf16_t* xpn = xp + (size_t)((m == 3 ? 128 - 48 : 16)) * D;
#pragma unroll
                        for (int bj = 0; bj < 2; ++bj) xnb[bj] = *(const u32x4*)(xpn + bj * 128); }
                }
                float ss = 0.f;
#pragma unroll
                for (int bj = 0; bj < 2; ++bj) {
                    const f32x4 x0 = xc[bj][0] + gt[bj][0] * acc[ai][bj][m][0], x1 = xc[bj][1] + gt[bj][1] * acc[ai][bj][m][1];
                    if (is_last) { __builtin_nontemporal_store(x0, (f32x4*)(op + bj * 128)); __builtin_nontemporal_store(x1, (f32x4*)(op + bj * 128 + 4)); }
                    else { u32x4 wx; wx.x = pk2(x0[0], x0[1]); wx.y = pk2(x0[2], x0[3]); wx.z = pk2(x1[0], x1[1]); wx.w = pk2(x1[2], x1[3]); *(u32x4*)(xp + bj * 128) = wx; }
                    if (ng) {
                        ss += ((x0[0] * x0[0] + x0[1] * x0[1]) + (x0[2] * x0[2] + x0[3] * x0[3])) + ((x1[0] * x1[0] + x1[1] * x1[1]) + (x1[2] * x1[2] + x1[3] * x1[3]));
                        const f32x4 h0 = x0 * gs[bj][0], h1 = x1 * gs[bj][1];
                        u32x4 wh; wh.x = pk2(h0[0], h0[1]); wh.y = pk2(h0[2], h0[3]); wh.z = pk2(h1[0], h1[1]); wh.w = pk2(h1[2], h1[3]);
                        *(u32x4*)(hp + bj * 128) = wh;
                    }
                }
                if (ng) {
                    ss += __shfl_xor(ss, 16); ss += __shfl_xor(ss, 32);
                    if (fq == 0) ssl[rl * 4 + wc] = ss;
                }
            }
        if (ng) {
            asm volatile("s_waitcnt lgkmcnt(0)" ::: "memory"); __builtin_amdgcn_s_barrier(); asm volatile("" ::: "memory");
            const int t = wr * 256 + wc * 64 + fq * 16 + fr;
            if (t < 256) { const f32x4 a = *(const LAS f32x4*)(ssl + t * 4); ssp[(size_t)(u.pm * 256 + t) * 4 + u.pn] = (a[0] + a[1]) + (a[2] + a[3]); }
        }
    }
};
struct EpiBias {
    ECtx c;
    __device__ __forceinline__ void operator()(const f32x4 (&acc)[2][2][4][2], const pg8::Unit& u, int wr, int wc, int fr, int fq) const {
        float* bias = (float*)(c.kp->ws + WS_BIAS) + (size_t)c.l * 9 * NB;
        const int which = u.pn < 22 ? 0 : (u.pn < 31 ? 1 : 2);
        if (wr != 0) return;
#pragma unroll
        for (int m = 0; m < 2; ++m) {
            const int kind = m * 16 + fr - 9 * which;
            if (kind >= 0 && kind < 9) {
#pragma unroll
                for (int bj = 0; bj < 2; ++bj)
#pragma unroll
                    for (int n = 0; n < 2; ++n) *(f32x4*)(bias + (size_t)kind * NB + u.pn * 256 + bj * 128 + wc * 32 + n * 16 + fq * 4) = acc[0][bj][m][n];
            }
        }
    }
};
struct EpiIn {
    ECtx c;
    __device__ __forceinline__ void operator()(const f32x4 (&acc)[2][2][4][2], const pg8::Unit& u, int wr, int wc, int fr, int fq) const {
        unsigned char* ws = c.kp->ws; float* out = c.kp->out; const int layer = c.l;
        const float* qg = c.kp->q_norm_g + layer * 64; const float* kg = c.kp->k_norm_g + layer * 64; const float* vng = c.kp->sg_vnorm_g + layer * 256;
        const float* ssp = (const float*)(ws + WS_SSP); const float* bias = (const float*)(ws + WS_BIAS) + (size_t)layer * 9 * NB + 5632;
        const int pn = u.pn;
        const int kind = u.pm < 32 ? 0 : 1 + ((u.pm - 32) >> 2);
        const float* sbase = ssp + (size_t)(u.pm * 256 + wr * 64 + fr) * 4;
        f32x4 sn = *(const f32x4*)sbase;
        f32x4 bz[2][2];
#pragma unroll
        for (int bj = 0; bj < 2; ++bj)
#pragma unroll
            for (int n = 0; n < 2; ++n) bz[bj][n] = *(const f32x4*)(bias + (size_t)kind * NB + pn * 256 + bj * 128 + wc * 32 + n * 16 + fq * 4);
#pragma unroll
        for (int ai = 0; ai < 2; ++ai)
#pragma unroll
            for (int m = 0; m < 4; ++m) {
                int row = u.pm * 256 + ai * 128 + wr * 64 + m * 16 + fr; asm volatile("" : "+v"(row));
                const float rs = rstd_of(sn);
                if (ai * 4 + m < 7) sn = *(const f32x4*)(sbase + (((m + 1) >> 2) + ai) * 512 + ((m + 1) & 3) * 64);
                f32x4 v[2][2];
#pragma unroll
                for (int bj = 0; bj < 2; ++bj)
#pragma unroll
                    for (int n = 0; n < 2; ++n) v[bj][n] = acc[ai][bj][m][n] * rs + bz[bj][n];
#define PK8(dst16, x0, x1) do { u32x4 w_; w_.x = pk2((x0)[0], (x0)[1]); w_.y = pk2((x0)[2], (x0)[3]); w_.z = pk2((x1)[0], (x1)[1]); w_.w = pk2((x1)[2], (x1)[3]); *(u32x4*)(dst16) = w_; } while (0)
                if (pn == 0) {
                    bf16_t* za = (bf16_t*)(ws + WS_ZA) + (size_t)row * 256 + wc * 64 + fq * 8;
#pragma unroll
                    for (int bj = 0; bj < 2; ++bj) PK8(za + bj * 32, v[bj][0], v[bj][1]);
                } else if (pn <= 4) {
                    const bool isk = pn >= 3; const int h = (isk ? pn - 3 : pn - 1) * 4 + wc;
                    bf16_t* qb = (bf16_t*)(ws + WS_Q); bf16_t* kb = (bf16_t*)(ws + WS_K);
                    float ss = 0.f;
#pragma unroll
                    for (int bj = 0; bj < 2; ++bj)
#pragma unroll
                        for (int n = 0; n < 2; ++n) ss += (v[bj][n][0] * v[bj][n][0] + v[bj][n][1] * v[bj][n][1]) + (v[bj][n][2] * v[bj][n][2] + v[bj][n][3] * v[bj][n][3]);
                    ss += __shfl_xor(ss, 16); ss += __shfl_xor(ss, 32);
                    const float rstd = __builtin_amdgcn_rsqf(ss * (1.0f / 64.0f) + EPS);
                    const float* gn = isk ? kg : qg;
                    bf16_t* dst = isk ? kb + ((size_t)h * M + (row & ~31)) * 64 + (fq >> 1) * 512 + (row & 31) * 16 + (fq & 1) * 8 : qb + ((size_t)h * M + row) * 64 + fq * 8;
#pragma unroll
                    for (int bj = 0; bj < 2; ++bj) {
                        const int dd = bj * 32 + fq * 8;
                        const float qs = isk ? rstd : rstd * (0.125f * LOG2E);
                        const f32x4 o0 = v[bj][0] * qs * *(const f32x4*)(gn + dd), o1 = v[bj][1] * qs * *(const f32x4*)(gn + dd + 4);
                        PK8(dst + (isk ? bj * 1024 : bj * 32), o0, o1);
                        if (isk && row < MCTX) { float* nk = out + NK_OFF + ((((size_t)(row >> 8) * 2 + layer) * 8 + h) * 256 + (row & 255)) * 64 + dd; __builtin_nontemporal_store(o0, (f32x4*)nk); __builtin_nontemporal_store(o1, (f32x4*)(nk + 4)); }
                    }
                } else if (pn <= 6) {
                    const int h = (pn - 5) * 4 + wc;
                    bf16_t* vt = (bf16_t*)(ws + WS_VT);
                    bf16_t* vrow = vt + ((size_t)h * M + (row & ~31)) * 64 + ((row >> 3) & 1) * 512 + ((row >> 4) & 1) * 8 + (row & 7) + fq * 128;
#pragma unroll
                    for (int bj = 0; bj < 2; ++bj)
#pragma unroll
                        for (int n = 0; n < 2; ++n) {
#pragma unroll
                            for (int j = 0; j < 4; ++j) vrow[bj * 1024 + n * 64 + j * 16] = (bf16_t)f2bf(v[bj][n][j]);
                            if (row < MCTX) __builtin_nontemporal_store(v[bj][n], (f32x4*)(out + NV_OFF + ((((size_t)(row >> 8) * 2 + layer) * 8 + h) * 256 + (row & 255)) * 64 + bj * 32 + fq * 8 + n * 4));
                        }
                } else if (pn == 7) {
                    bf16_t* ut = (bf16_t*)(ws + WS_UT) + (size_t)row * 256 + wc * 64 + fq * 8;
#pragma unroll
                    for (int bj = 0; bj < 2; ++bj) {
                        f32x4 g0, g1;
#pragma unroll
                        for (int j = 0; j < 4; ++j) { g0[j] = gelu_tanh(v[bj][0][j]); g1[j] = gelu_tanh(v[bj][1][j]); }
                        PK8(ut + bj * 32, g0, g1);
                    }
                } else {
                    float ss = 0.f;
#pragma unroll
                    for (int bj = 0; bj < 2; ++bj)
#pragma unroll
                        for (int n = 0; n < 2; ++n) {
#pragma unroll
                            for (int j = 0; j < 4; ++j) { v[bj][n][j] = gelu_tanh(v[bj][n][j]); ss += v[bj][n][j] * v[bj][n][j]; }
                        }
                    ss += __shfl_xor(ss, 16); ss += __shfl_xor(ss, 32);
                    const float rstd = __builtin_amdgcn_rsqf(ss * (1.0f / 64.0f) + EPS);
                    bf16_t* vgt = (bf16_t*)(ws + WS_VGT);
                    bf16_t* vgrow = vgt + (size_t)(row >> 7) * 32768 + ((row >> 4) & 7) * 512 + ((row >> 3) & 1) * 8 + (row & 7) + wc * 8192 + fq * 128;
#pragma unroll
                    for (int bj = 0; bj < 2; ++bj)
#pragma unroll
                        for (int n = 0; n < 2; ++n) {
                            const f32x4 o = v[bj][n] * rstd * *(const f32x4*)(vng + wc * 64 + bj * 32 + fq * 8 + n * 4);
#pragma unroll
                            for (int j = 0; j < 4; ++j) vgrow[bj * 4096 + n * 64 + j * 16] = (bf16_t)f2bf(o[j]);
                        }
                }
#undef PK8
            }
    }
};

struct EpiAll {
    ECtx c0;
    __device__ __forceinline__ void operator()(const f32x4 (&acc)[2][2][4][2], const pg8::Unit& u, int wr, int wc, int fr, int fq) const {
        ECtx c = c0; asm volatile("" : "+s"(c.kp));
        if (u.pm < 0) { ECtx cb = c; cb.l = 1; pg8::Unit ub; ub.pm = 0; ub.pn = u.pn - 48; EpiBias{cb}(acc, ub, wr, wc, fr, fq); }
        else if (c.k == 0 || c.k == 5) EpiSwiglu{c}(acc, u, wr, wc, fr, fq); else if (c.k == 2) EpiIn{c}(acc, u, wr, wc, fr, fq); else if (c.k < 0) EpiBias{c}(acc, u, wr, wc, fr, fq); else EpiRes{c}(acc, u, wr, wc, fr, fq);
    }
};
struct Frame {
    LAS unsigned char* lds;
    int tid, lane, wave, G, bid;
};

__device__ __forceinline__ void transpose_item(const float* src  , int sstride, int K, bf16_t* WT, int n0, int k0, LAS float* scr, int lane, bool ntst) {
    float tv[32];
#pragma unroll
    for (int i = 0; i < 32; ++i) tv[i] = __builtin_nontemporal_load(src + (size_t)(k0 + 2 * i + (lane >> 5)) * sstride);
#pragma unroll
    for (int i = 0; i < 32; ++i) scr[(2 * i + (lane >> 5)) * 33 + (lane & 31)] = tv[i];
    asm volatile("s_waitcnt lgkmcnt(0)" ::: "memory");
    const int c = lane & 7;
#pragma unroll
    for (int j = 0; j < 4; ++j) { const int n = (lane >> 3) + 8 * j; const LAS float* s = scr + (8 * c) * 33 + n;
        u32x4 o; o.x = pk2(s[0 * 33], s[1 * 33]); o.y = pk2(s[2 * 33], s[3 * 33]); o.z = pk2(s[4 * 33], s[5 * 33]); o.w = pk2(s[6 * 33], s[7 * 33]);
        if (ntst) __builtin_nontemporal_store(o, (u32x4*)(WT + (size_t)(n0 + n) * K + k0 + 8 * c)); else *(u32x4*)(WT + (size_t)(n0 + n) * K + k0 + 8 * c) = o; }
    asm volatile("s_waitcnt lgkmcnt(0)" ::: "memory");
}

constexpr int CV_GU = 16 * 176, CV_D = 44 * 32, CV_IN = 16 * 72, CV_OUT = 16 * 32, CV_NA = 2 * CV_GU + CV_IN, CV_LAYER = CV_NA + 2 * CV_D + CV_OUT;
__device__ __forceinline__ void convert_items(const Params& p, Frame& F, int l, int lo, int hi, int widx, int nw) {
    LAS float* scr = (LAS float*)(F.lds + F.wave * 16896);
    unsigned char* wl = p.ws + WS_W + (size_t)l * W_LAYER;
    const int q = F.lane & 31;
    for (int it = lo + widx; it < hi; it += nw) {
        int r = it;
        if (r < 2 * CV_GU) {
            const int f = r / CV_GU; r %= CV_GU; const int kb = r / 176, nb = r % 176, n0 = nb * 32;
            const int tile = n0 >> 8, p0 = n0 & 255, ffcol = tile * 128 + 32 * ((p0 >> 5) & 3) + 8 * ((q & 15) >> 2) + 4 * (p0 >> 7) + (q & 3);
            const float* src = ((q >> 4) ? p.w_up : p.w_gate) + (size_t)(l * 2 + f) * D * FF + ffcol;
            transpose_item(src, FF, D, (bf16_t*)(wl + (f ? W_GU1 : W_GU0)), n0, kb * 64, scr, F.lane, l == 1); continue; }
        r -= 2 * CV_GU;
        if (r < CV_IN) {
            const int kb = r / 72, nb = r % 72, n0 = nb * 32, p0 = n0 & 255;
            const int lcol = (n0 & ~255) + 64 * ((p0 >> 5) & 3) + 32 * (p0 >> 7) + 8 * ((q & 15) >> 2) + 4 * (q >> 4) + (q & 3);
            const float* src = p.w_in + (size_t)l * D * NIN + lcol;
            transpose_item(src, NIN, D, (bf16_t*)(wl + W_IN), n0, kb * 64, scr, F.lane, l == 1); continue; }
        r -= CV_IN;
        if (r < 2 * CV_D) {
            const int f = r / CV_D; r %= CV_D; const int kb = r / 32, nb = r % 32, n0 = nb * 32;
            const float* src = p.w_down + (size_t)(l * 2 + f) * FF * D + n0 + (8 * ((q & 15) >> 2) + 4 * (q >> 4) + (q & 3));
            transpose_item(src, D, FF, (bf16_t*)(wl + W_D + f * W_D_SZ), n0, kb * 64, scr, F.lane, l == 1); continue; }
        r -= 2 * CV_D;
        { const int kb = r / 32, nb = r % 32, n0 = nb * 32;
          const float* src = p.w_out + (size_t)l * D * D + n0 + (8 * ((q & 15) >> 2) + 4 * (q >> 4) + (q & 3));
          transpose_item(src, D, D, (bf16_t*)(wl + W_OUT), n0, kb * 64, scr, F.lane, l == 1); }
    }
}

__device__ __forceinline__ void phase_prologue(const Params& p, Frame& F) {
    float* MOD = (float*)(p.ws + WS_MOD);
    for (int item = F.bid; item < 144; item += F.G) {
        const int l = item / 72, jc = item % 72;
        LAS float* sc = (LAS float*)F.lds; LAS float* red = sc + 9 * 1024;
        for (int i = F.tid; i < 9 * 1024; i += 512) { const int s = i >> 10, k = i & 1023; const float v = s == 0 ? p.c_ctx[k] : p.c[(s - 1) * 1024 + k]; sc[i] = silu_f(v); }
        __syncthreads();
        const float* w = p.ada_w + (size_t)l * 1024 * 9216 + (size_t)(F.wave * 128) * 9216 + jc * 128 + F.lane * 2;
        f32x2 acc[9];
#pragma unroll
        for (int s = 0; s < 9; ++s) acc[s] = (f32x2){0.f, 0.f};
        for (int k0 = 0; k0 < 128; k0 += 32) {
            f32x2 wv[32];
#pragma unroll
            for (int k = 0; k < 32; ++k) wv[k] = __builtin_nontemporal_load((const f32x2*)(w + (size_t)(k0 + k) * 9216));
#pragma unroll
            for (int k = 0; k < 32; ++k) {
#pragma unroll
                for (int s = 0; s < 9; ++s) acc[s] += sc[s * 1024 + F.wave * 128 + k0 + k] * wv[k];
            }
        }
#pragma unroll
        for (int s = 0; s < 9; ++s) { red[(F.wave * 9 + s) * 128 + F.lane * 2] = acc[s].x; red[(F.wave * 9 + s) * 128 + F.lane * 2 + 1] = acc[s].y; }
        __syncthreads();
        for (int i = F.tid; i < 9 * 128; i += 512) { const int s = i >> 7, j = i & 127; float sum = p.ada_b[l * 9216 + jc * 128 + j];
#pragma unroll
            for (int w8 = 0; w8 < 8; ++w8) sum += red[(w8 * 9 + s) * 128 + j];
            MOD[(size_t)(l * 9 + s) * 9216 + jc * 128 + j] = sum;
            const int mi = jc >> 3;
            if (mi % 3 == 0) ((bf16_t*)(p.ws + WS_SHB))[((size_t)l * 256 + 9 * (mi / 3) + s) * 1024 + (jc & 7) * 128 + j] = (bf16_t)f2bf(sum); }
        __syncthreads();
    }
    const int gw = F.bid * 8 + F.wave, NGW = F.G * 8;
    LAS float* scr = (LAS float*)(F.lds + F.wave * 16896);
    { unsigned* z = (unsigned*)(p.ws + WS_SHB);
      for (int i = gw * 64 + F.lane; i < 2 * 229 * 512; i += NGW * 64) { const int l = i / (229 * 512), r = i % (229 * 512); z[((size_t)l * 256 + 27) * 512 + r] = 0u; } }
    { bf16_t* SW = (bf16_t*)(p.ws + WS_SW);
      for (int i = gw * 64 + F.lane; i < 2 * 4 * 128 * 128 / 2; i += NGW * 64) { const f32x2 v = *(const f32x2*)(p.sg_w + 2 * (size_t)i); ((unsigned*)SW)[i] = pk2(v.x, v.y); } }
    { bf16_t* PW = (bf16_t*)(p.ws + WS_PW);
      for (int i = gw * 64 + F.lane; i < 2 * 4 * 64 * 64; i += NGW * 64) { const int c = i & 63, d = (i >> 6) & 63, lg = i >> 12; PW[i] = (bf16_t)f2bf(p.pool_w[((size_t)lg * 64 + c) * 64 + d]); } }
    { bf16_t* CK = (bf16_t*)(p.ws + WS_CK); bf16_t* CVT = (bf16_t*)(p.ws + WS_CVT);
      const bool split = F.G == 256;
      const int cw = split ? gw - 144 * 8 : gw, cnw = split ? (256 - 144) * 8 : NGW;
      if (cw >= 0)
      for (int it = cw; it < 128 * 4; it += cnw) {
          const int mat = it >> 2, t0 = (it & 3) * 64;
          const float* ks = p.cache_k + ((size_t)mat * 256 + t0) * 64; const float* vs = p.cache_v + ((size_t)mat * 256 + t0) * 64;
          const int d = F.lane;
          for (int tq = 0; tq < 64; tq += 16) {
              float kv[16], vv[16];
#pragma unroll
              for (int t = 0; t < 16; ++t) { kv[t] = __builtin_nontemporal_load(ks + (tq + t) * 64 + d); vv[t] = __builtin_nontemporal_load(vs + (tq + t) * 64 + d); }
#pragma unroll
              for (int t = 0; t < 16; ++t) {
                  const int tt = t0 + tq + t, key = tt & 31; const size_t tb = ((size_t)mat * 8 + (tt >> 5)) * 2048;
                  CK[tb + ((d >> 4) * 32 + key) * 16 + (d & 15)] = (bf16_t)f2bf(kv[t]);
                  CVT[tb + (((d >> 5) * 2 + ((key >> 3) & 1)) * 32 + (d & 31)) * 16 + (key >> 4) * 8 + (key & 7)] = (bf16_t)f2bf(vv[t]);
              }
          }
      } }
    convert_items(p, F, 0, 0, CV_NA, gw, NGW);
    if (F.G != 256) { convert_items(p, F, 0, CV_NA, CV_LAYER, gw, NGW); convert_items(p, F, 1, 0, CV_LAYER, gw, NGW); }
}

__device__ __forceinline__ void phase_norm0(const Params& p, Frame& F) {
    bf16_t* H = (bf16_t*)(p.ws + WS_H); float* SSP = (float*)(p.ws + WS_SSP);
    const float* modl = (const float*)(p.ws + WS_MOD);
    const bool split = F.G == 256;
    if (split && F.bid < 53) return;
    const int gw = (split ? F.bid - 53 : F.bid) * 8 + F.wave, NGW = (split ? F.G - 53 : F.G) * 8;
    for (int r0 = gw * 8; r0 < M; r0 += NGW * 8) {
        const int kind = kind_of_row(r0);
        const float* sc = modl + (size_t)(kind * 9 + 1) * 1024;
        f32x4 gs[4];
#pragma unroll
        for (int j = 0; j < 4; ++j) { const int col = 4 * F.lane + 256 * j; gs[j] = *(const f32x4*)(p.norm_g + col) * (*(const f32x4*)(sc + col) + 1.0f); }
#pragma unroll 4
        for (int rr = 0; rr < 8; ++rr) {
            const int row = r0 + rr;
            const float* xr = row < MCTX ? p.x_prompt + (size_t)row * D : p.x_sample + (size_t)(row - MCTX) * D;
            f32x4 v[4]; float s = 0.f;
#pragma unroll
            for (int j = 0; j < 4; ++j) { v[j] = __builtin_nontemporal_load((const f32x4*)(xr + 4 * F.lane + 256 * j)); s += (v[j][0] * v[j][0] + v[j][1] * v[j][1]) + (v[j][2] * v[j][2] + v[j][3] * v[j][3]); }
            s = wave_sum(s);
            if (F.lane < 4) SSP[(size_t)row * 4 + F.lane] = F.lane == 0 ? s : 0.f;
#pragma unroll
            for (int j = 0; j < 4; ++j) { const f32x4 o = v[j] * gs[j]; u32x2 w; w.x = pk2(o[0], o[1]); w.y = pk2(o[2], o[3]);
                *(u32x2*)(H + (size_t)row * D + 4 * F.lane + 256 * j) = w; }
        }
    }
}

__device__ __forceinline__ float half_max(float v) {
    const auto rr = __builtin_amdgcn_permlane32_swap(__builtin_bit_cast(unsigned, v), __builtin_bit_cast(unsigned, v), false, false);
    return fmaxf(__builtin_bit_cast(float, (unsigned)rr[0]), __builtin_bit_cast(float, (unsigned)rr[1]));
}
__device__ __forceinline__ float half_sum(float v) {
    const auto rr = __builtin_amdgcn_permlane32_swap(__builtin_bit_cast(unsigned, v), __builtin_bit_cast(unsigned, v), false, false);
    return __builtin_bit_cast(float, (unsigned)rr[0]) + __builtin_bit_cast(float, (unsigned)rr[1]);
}
struct AttnState { f32x16 O0, O1; float m, l; };
struct KF { bf16x8 k[4]; };
struct VF { bf16x8 v[2][2]; };
__device__ __forceinline__ void load_k(KF& f, const bf16_t* Kp, int lane) {
    const int rho = lane & 31, key = 16 * ((rho >> 2) & 1) + 4 * (rho >> 3) + (rho & 3);
    const bf16_t* kp = Kp + key * 16 + (lane >> 5) * 8;
#pragma unroll
    for (int c = 0; c < 4; ++c) f.k[c] = *(const bf16x8*)(kp + 512 * c);
}
__device__ __forceinline__ void load_v(VF& f, const bf16_t* Vp, int lane) {
    const bf16_t* vp = Vp + (lane & 31) * 16 + (lane >> 5) * 8;
#pragma unroll
    for (int mb = 0; mb < 2; ++mb)
#pragma unroll
        for (int c = 0; c < 2; ++c) f.v[mb][c] = *(const bf16x8*)(vp + (mb * 2 + c) * 512);
}
template <bool LOCAL>
__device__ __forceinline__ f32x16 qk_part(const bf16x8 (&qf)[4], const KF& f, int lane, const LAS float* bl, int th, int qc, int cs) {
    const int g = lane >> 5;
    f32x16 S;
#pragma unroll
    for (int i = 0; i < 16; ++i) S[i] = 0.f;
#pragma unroll
    for (int c = 0; c < 4; ++c) S = __builtin_amdgcn_mfma_f32_32x32x16_bf16(f.k[c], qf[c], S, 0, 0, 0);
    if (LOCAL) {
        const LAS float* bp = bl + (63 + th * 32 + 16 * g - qc);
        const int rel0 = th * 32 + 16 * g - cs;
        float bv[16];
#pragma unroll
        for (int i = 0; i < 16; ++i) bv[i] = bp[i];
#pragma unroll
        for (int i = 0; i < 16; ++i) {
            const float pen = (unsigned)(rel0 + i) < 16u ? 0.f : -1e30f;
            S[i] = (S[i] + bv[i]) + pen;
        }
    }
    return S;
}
__device__ __forceinline__ void pv_part(AttnState& st, f32x16 S, const VF& f) {
    float mt = S[0];
#pragma unroll
    for (int i = 1; i < 16; ++i) mt = fmaxf(mt, S[i]);
    mt = half_max(mt);
    if (__any(mt - st.m > 8.0f)) {
        const float mn = fmaxf(st.m, mt);
        const float alpha = __builtin_amdgcn_exp2f(st.m - mn);
        st.m = mn; st.l *= alpha;
#pragma unroll
        for (int i = 0; i < 16; ++i) { st.O0[i] *= alpha; st.O1[i] *= alpha; }
    }
    float ps = 0.f;
#pragma unroll
    for (int i = 0; i < 16; ++i) { S[i] = __builtin_amdgcn_exp2f(S[i] - st.m); ps += S[i]; }
    st.l += ps;
    bf16x8 pf[2];
#pragma unroll
    for (int c = 0; c < 2; ++c) {
        u32x4 w; w.x = pk2(S[8 * c + 0], S[8 * c + 1]); w.y = pk2(S[8 * c + 2], S[8 * c + 3]); w.z = pk2(S[8 * c + 4], S[8 * c + 5]); w.w = pk2(S[8 * c + 6], S[8 * c + 7]);
        pf[c] = __builtin_bit_cast(bf16x8, w);
    }
#define VFR(mb, c) (f.v[mb][c])
    st.O0 = __builtin_amdgcn_mfma_f32_32x32x16_bf16(VFR(0, 0), pf[0], st.O0, 0, 0, 0);
    st.O0 = __builtin_amdgcn_mfma_f32_32x32x16_bf16(VFR(0, 1), pf[1], st.O0, 0, 0, 0);
    st.O1 = __builtin_amdgcn_mfma_f32_32x32x16_bf16(VFR(1, 0), pf[0], st.O1, 0, 0, 0);
    st.O1 = __builtin_amdgcn_mfma_f32_32x32x16_bf16(VFR(1, 1), pf[1], st.O1, 0, 0, 0);
#undef VFR
}
template <bool LOCAL>
__device__ __forceinline__ void attn_run(AttnState& st, const bf16x8 (&qf)[4], const bf16_t* K0, const bf16_t* V0, int ntiles, int lane,
                                         const LAS float* rpbL, int r, int start, int qc, int cs) {
    KF ka, kb; VF va, vb;
    load_k(ka, K0, lane); load_v(va, V0, lane);
    for (int t = 0; t < ntiles; t += 2) {
        const LAS float* bl = rpbL + (start + (t >> 1) - r + 7) * 128;
        load_k(kb, K0 + (size_t)(t + 1) * 2048, lane);
        f32x16 S = qk_part<LOCAL>(qf, ka, lane, bl, 0, qc, cs);
        load_v(vb, V0 + (size_t)(t + 1) * 2048, lane);
        pv_part(st, S, va);
        const int tn = t + 2 < ntiles ? t + 2 : 0;
        load_k(ka, K0 + (size_t)tn * 2048, lane);
        S = qk_part<LOCAL>(qf, kb, lane, bl, 1, qc, cs);
        load_v(va, V0 + (size_t)tn * 2048, lane);
        pv_part(st, S, vb);
    }
}
__device__ __forceinline__ void attn_finish(Frame& F, AttnState& st, int q0, int h, const float* gb  , bf16_t* OB) {
    const int g = F.lane >> 5, ql = F.lane & 31;
    const float lt = half_sum(st.l);
    const float inv = 1.0f / lt;
    float ss = 0.f;
#pragma unroll
    for (int i = 0; i < 16; ++i) { st.O0[i] *= inv; st.O1[i] *= inv; ss += st.O0[i] * st.O0[i] + st.O1[i] * st.O1[i]; }
    ss = half_sum(ss);
    LAS float* hs = (LAS float*)(F.lds + 61440);
    if (g == 0) hs[h * 32 + ql] = ss;
    __syncthreads();
    float tot = 0.f;
#pragma unroll
    for (int hh = 0; hh < 8; ++hh) tot += hs[hh * 32 + ql];
    const float rstd = __builtin_amdgcn_rsqf(tot * (1.0f / 512.0f) + EPS);
    bf16_t* orow = OB + (size_t)(q0 + ql) * D + 256 + h * 64;
#pragma unroll
    for (int mb = 0; mb < 2; ++mb)
#pragma unroll
        for (int i = 0; i < 4; ++i) {
            const int d = 32 * mb + 8 * i + 4 * g;
            const f32x4 gv = *(const f32x4*)(gb + h * 64 + d);
            float o[4];
#pragma unroll
            for (int j = 0; j < 4; ++j) o[j] = (mb == 0 ? st.O0[4 * i + j] : st.O1[4 * i + j]) * rstd * gv[j];
            u32x2 w; w.x = pk2(o[0], o[1]); w.y = pk2(o[2], o[3]);
            *(u32x2*)(orow + d) = w;
        }
    __syncthreads();
}

__device__ __forceinline__ void pool_unit(const Params& p, Frame& F, int l, int u, const bf16_t* ZA, const bf16_t* PWT, bf16_t* OB, const float* ong) {
    const int lane = F.lane, g2 = lane >> 5, ql = lane & 31, w = F.wave;
    const int row0 = u * 32;
    const int seq0 = row0 < MCTX ? (row0 & ~255) : MCTX + ((row0 - MCTX) & ~1023);
    const int L = row0 < MCTX ? 256 : 1024, tloc = row0 - seq0;
    LAS float* A = (LAS float*)F.lds;
    LAS float* P = A + 48 * 256;
    LAS float* part = P + 32 * 260;
    bf16x8 af[4];
    { const bf16_t* ap = PWT + ((size_t)(l * 4 + (w >> 1)) * 64 + 32 * (w & 1) + ql) * 64 + 8 * g2;
#pragma unroll
      for (int kc = 0; kc < 4; ++kc) af[kc] = *(const bf16x8*)(ap + 16 * kc); }
    {
        unsigned wd[12];
#pragma unroll
        for (int it = 0; it < 12; ++it) { const int i = F.tid + it * 512, rr = i >> 7, cp = i & 127, tl = tloc - 8 + rr;
            wd[it] = 0u; if (tl >= 0 && tl < L) wd[it] = *(const unsigned*)(ZA + (size_t)(seq0 + tl) * 256 + 2 * cp); }
#pragma unroll
        for (int it = 0; it < 12; ++it) { const int i = F.tid + it * 512, rr = i >> 7, cp = i & 127;
            A[rr * 256 + 2 * cp] = __builtin_bit_cast(float, wd[it] << 16); A[rr * 256 + 2 * cp + 1] = __builtin_bit_cast(float, wd[it] & 0xffff0000u); }
    }
    __syncthreads();
    {
        const int ch = F.tid & 255, thh = F.tid >> 8, gi = ch >> 6;
        float a[31];
#pragma unroll
        for (int i = 0; i < 31; ++i) a[i] = A[(16 * thh + i) * 256 + ch];
#define POOL_WIN(HALF) do { _Pragma("unroll") for (int t = 0; t < 16; ++t) { float sm = 0.f; _Pragma("unroll") for (int j = -HALF; j < HALF; ++j) sm += a[8 + t + j]; \
            const int tl = tloc + 16 * thh + t; const int lo = max(tl - HALF, 0), hi = min(tl + HALF, L); \
            P[(16 * thh + t) * 260 + ch] = sm * __builtin_amdgcn_rcpf((float)(hi - lo)) - a[8 + t]; } } while (0)
        if (gi == 0) POOL_WIN(1); else if (gi == 1) POOL_WIN(2); else if (gi == 2) POOL_WIN(4); else POOL_WIN(8);
#undef POOL_WIN
    }
    __syncthreads();
    f32x16 Dm;
#pragma unroll
    for (int i = 0; i < 16; ++i) Dm[i] = 0.f;
    { const LAS float* pp = P + ql * 260 + (w >> 1) * 64 + 8 * g2;
#pragma unroll
      for (int kc = 0; kc < 4; ++kc) {
          const f32x4 x0 = *(const LAS f32x4*)(pp + 16 * kc), x1 = *(const LAS f32x4*)(pp + 16 * kc + 4);
          u32x4 wd; wd.x = pk2(x0[0], x0[1]); wd.y = pk2(x0[2], x0[3]); wd.z = pk2(x1[0], x1[1]); wd.w = pk2(x1[2], x1[3]);
          Dm = __builtin_amdgcn_mfma_f32_32x32x16_bf16(af[kc], __builtin_bit_cast(bf16x8, wd), Dm, 0, 0, 0);
      } }
    float ss = 0.f;
#pragma unroll
    for (int i = 0; i < 4; ++i) { const f32x4 ps = *(const f32x4*)(p.pool_scale + l * 256 + 32 * w + 8 * i + 4 * g2);
#pragma unroll
        for (int j = 0; j < 4; ++j) { Dm[4 * i + j] *= ps[j]; ss += Dm[4 * i + j] * Dm[4 * i + j]; } }
    ss = half_sum(ss);
    if (g2 == 0) part[w * 32 + ql] = ss;
    __syncthreads();
    float tot = 0.f;
#pragma unroll
    for (int w8 = 0; w8 < 8; ++w8) tot += part[w8 * 32 + ql];
    const float rstd = __builtin_amdgcn_rsqf(tot * (1.0f / 256.0f) + EPS);
#pragma unroll
    for (int i = 0; i < 4; ++i) { const int oc = 32 * w + 8 * i + 4 * g2; const f32x4 gv = *(const f32x4*)(ong + oc);
        u32x2 wv; wv.x = pk2(Dm[4 * i] * rstd * gv[0], Dm[4 * i + 1] * rstd * gv[1]); wv.y = pk2(Dm[4 * i + 2] * rstd * gv[2], Dm[4 * i + 3] * rstd * gv[3]);
        *(u32x2*)(OB + (size_t)(row0 + ql) * D + oc) = wv; }
    __syncthreads();
}

__device__ __forceinline__ void chunk_unit(const Params& p, Frame& F, int l, int u, const bf16_t* UB, const bf16_t* VGT, const bf16_t* SW, bf16_t* OB, const float* ong) {
    const int lane = F.lane, g = lane >> 5, ql = lane & 31;
    const int row0 = u * 128, w = F.wave, tb = w & 3, chh = w >> 2;
    const int tok = row0 + 32 * tb + ql;
    LAS float* part = (LAS float*)F.lds;
    float outv[2][2][16]; float ss = 0.f;
#pragma unroll
    for (int gs = 0; gs < 2; ++gs) {
        const int gi = 2 * chh + gs;
        bf16x8 bw[8];
        const bf16_t* wp = SW + ((size_t)(l * 4 + gi) * 128 + 32 * tb + ql) * 128 + 8 * g;
#pragma unroll
        for (int kc = 0; kc < 8; ++kc) bw[kc] = *(const bf16x8*)(wp + 16 * kc);
        const float bsv = p.sg_b[(size_t)(l * 4 + gi) * 128 + 32 * tb + ql];
#pragma unroll
        for (int cb = 0; cb < 2; ++cb) {
            const int ch0 = 64 * gi + 32 * cb;
            const bf16_t* ap = VGT + ((size_t)(u * 8 + 2 * gi + cb) * 8) * 512 + ql * 16 + 8 * g;
            s16x4 uv[4];
#pragma unroll
            for (int i = 0; i < 4; ++i) uv[i] = *(const s16x4*)(UB + (size_t)tok * 256 + ch0 + 8 * i + 4 * g);
            f32x16 Dm;
#pragma unroll
            for (int i = 0; i < 16; ++i) Dm[i] = 0.f;
#pragma unroll
            for (int kc = 0; kc < 8; ++kc) { const bf16x8 af = *(const bf16x8*)(ap + 512 * kc); Dm = __builtin_amdgcn_mfma_f32_32x32x16_bf16(af, bw[kc], Dm, 0, 0, 0); }
#pragma unroll
            for (int i = 0; i < 4; ++i)
#pragma unroll
                for (int j = 0; j < 4; ++j) { const float o = bf2f((unsigned short)uv[i][j]) * (Dm[4 * i + j] + bsv); outv[gs][cb][4 * i + j] = o; ss += o * o; }
        }
    }
    ss = half_sum(ss);
    if (g == 0) part[chh * 128 + 32 * tb + ql] = ss;
    __syncthreads();
    const float tot = part[32 * tb + ql] + part[128 + 32 * tb + ql];
    const float rstd = __builtin_amdgcn_rsqf(tot * (1.0f / 256.0f) + EPS);
#pragma unroll
    for (int gs = 0; gs < 2; ++gs)
#pragma unroll
        for (int cb = 0; cb < 2; ++cb)
#pragma unroll
            for (int i = 0; i < 4; ++i) {
                const int ch = 64 * (2 * chh + gs) + 32 * cb + 8 * i + 4 * g;
                const f32x4 gv = *(const f32x4*)(ong + 768 + ch);
                u32x2 wv; wv.x = pk2(outv[gs][cb][4 * i] * rstd * gv[0], outv[gs][cb][4 * i + 1] * rstd * gv[1]); wv.y = pk2(outv[gs][cb][4 * i + 2] * rstd * gv[2], outv[gs][cb][4 * i + 3] * rstd * gv[3]);
                *(u32x2*)(OB + (size_t)tok * D + 768 + ch) = wv;
            }
    __syncthreads();
}

__device__ __forceinline__ void phase_mix(const Params& p, Frame& F, int l) {
    const int lane = F.lane, h = F.wave, g = lane >> 5, ql = lane & 31;
    const int vb = (F.G % 8 == 0) ? (F.bid % 8) * (F.G / 8) + F.bid / 8 : F.bid;
    {
    const bf16_t* QB = (const bf16_t*)(p.ws + WS_Q); const bf16_t* KB = (const bf16_t*)(p.ws + WS_K); const bf16_t* VT = (const bf16_t*)(p.ws + WS_VT);
    const bf16_t* CK = (const bf16_t*)(p.ws + WS_CK); const bf16_t* CVT = (const bf16_t*)(p.ws + WS_CVT);
    bf16_t* OB = (bf16_t*)(p.ws + WS_OB);
    const float* ong = p.out_norm_g + l * 1024;
    for (int u = vb; u < 256; u += F.G) {
        const int b = u >> 5, r = (u >> 1) & 15, qh = u & 1;
        const int q0 = MCTX + b * 1024 + r * 64 + qh * 32;
        LAS float* rpbL = (LAS float*)(F.lds + F.wave * 7680);
        for (int i = lane; i < 15 * 128; i += 64) rpbL[i] = 0.f;
        { float tv[8];
#pragma unroll
          for (int k = 0; k < 8; ++k) { const int i = lane + 64 * k; tv[k] = i < 465 ? p.na_rpb[((size_t)l * 8 + h) * 465 + i] : 0.f; }
#pragma unroll
          for (int k = 0; k < 8; ++k) { const int i = lane + 64 * k; if (i < 465) rpbL[(i / 31) * 128 + 48 + (i % 31)] = tv[k] * LOG2E; } }
        bf16x8 qf[4];
#pragma unroll
        for (int c = 0; c < 4; ++c) qf[c] = *(const bf16x8*)(QB + ((size_t)h * M + q0 + ql) * 64 + 16 * c + 8 * g);
        AttnState st;
#pragma unroll
        for (int i = 0; i < 16; ++i) { st.O0[i] = 0.f; st.O1[i] = 0.f; }
        st.m = -1e30f; st.l = 0.f;
        const bf16_t* ck = CK + (size_t)((b * 2 + l) * 8 + h) * 256 * 64; const bf16_t* cvt = CVT + (size_t)((b * 2 + l) * 8 + h) * 64 * 256;
        attn_run<false>(st, qf, ck, cvt, 8, lane, rpbL, 0, 0, 0, 0);
        const int start = min(max(r - 4, 0), 8);
        const int qc = qh * 32 + ql, cs = min(max(qc - 8, 0), 48);
        const size_t toff = ((size_t)h * M + MCTX + b * 1024 + start * 64) * 64;
        attn_run<true>(st, qf, KB + toff, VT + toff, 16, lane, rpbL, r, start, qc, cs);
        attn_finish(F, st, q0, h, ong + 256, OB);
    }
    for (int u = vb; u < 256; u += F.G) {
        const int b = u >> 3, qb = u & 7, q0 = b * 256 + qb * 32;
        bf16x8 qf[4];
#pragma unroll
        for (int c = 0; c < 4; ++c) qf[c] = *(const bf16x8*)(QB + ((size_t)h * M + q0 + ql) * 64 + 16 * c + 8 * g);
        AttnState st;
#pragma unroll
        for (int i = 0; i < 16; ++i) { st.O0[i] = 0.f; st.O1[i] = 0.f; }
        st.m = -1e30f; st.l = 0.f;
        const size_t toff = ((size_t)h * M + b * 256) * 64;
        attn_run<false>(st, qf, KB + toff, VT + toff, 8, lane, (const LAS float*)F.lds, 0, 0, 0, 0);
        attn_finish(F, st, q0, h, ong + 256, OB);
    }
    }
    const bf16_t* ZA = (const bf16_t*)(p.ws + WS_ZA); const bf16_t* UB = (const bf16_t*)(p.ws + WS_UT); const bf16_t* VGT = (const bf16_t*)(p.ws + WS_VGT);
    const bf16_t* SW = (const bf16_t*)(p.ws + WS_SW); const bf16_t* PWT = (const bf16_t*)(p.ws + WS_PW);
    bf16_t* OB = (bf16_t*)(p.ws + WS_OB);
    const float* ong = p.out_norm_g + l * 1024;
    if (F.G == 256) {
        if (F.bid < 128) { chunk_unit(p, F, l, F.bid, UB, VGT, SW, OB, ong); pool_unit(p, F, l, F.bid, ZA, PWT, OB, ong); }
        else { for (int i = 0; i < 3; ++i) pool_unit(p, F, l, 128 + (F.bid - 128) * 3 + i, ZA, PWT, OB, ong); }
    } else {
        for (int u = F.bid; u < 128; u += F.G) chunk_unit(p, F, l, u, UB, VGT, SW, OB, ong);
        for (int u = F.bid; u < 512; u += F.G) pool_unit(p, F, l, u, ZA, PWT, OB, ong);
    }
}

#define XB_TMO      128
#define XB_XCNT(j)  (256  + 64 * (j))
#define XB_XSUB(j)  (1280 + 64 * (j))
#define XB_XGEN(j)  (2304 + 64 * (j))
#define XB_TOP      3328
#define XB_TOPGEN   3392
#define XCD_BAR_WORDS 3456
#define XB_SPIN_CAP (1u << 18)
__device__ __forceinline__ unsigned xb_ld(unsigned* p)              { return __hip_atomic_load(p, __ATOMIC_RELAXED, __HIP_MEMORY_SCOPE_AGENT); }
__device__ __forceinline__ unsigned xb_add(unsigned* p, unsigned v) { return __hip_atomic_fetch_add(p, v, __ATOMIC_RELAXED, __HIP_MEMORY_SCOPE_AGENT); }
__device__ __forceinline__ unsigned xb_xcc_id() { return (unsigned)__builtin_amdgcn_s_getreg((3 << 11) | 20) & 0xFu; }
#define XB_SPIN(cond, bar) do { unsigned _sp = 0; while (cond) { __builtin_amdgcn_s_sleep(1); \
    if ((++_sp & 255u) == 0u) { if (xb_ld(&(bar)[XB_TMO])) break; if (_sp > XB_SPIN_CAP) { atomicAdd(&(bar)[XB_TMO], 1u); break; } } } } while (0)
struct XcdBarrier { unsigned* bar; unsigned x; volatile LAS unsigned* st; };
__device__ __forceinline__ XcdBarrier xcd_barrier_post(unsigned* bar, volatile LAS unsigned* st) {
    XcdBarrier b; b.bar = bar; b.x = xb_xcc_id(); b.st = st;
    if (threadIdx.x == 0) (void)xb_add(&bar[XB_XCNT(b.x)], 1u);
    return b;
}
__device__ __forceinline__ void xcd_barrier_complete(unsigned* bar, unsigned x, unsigned& nloc, unsigned& nx) {
    const unsigned G = gridDim.x * gridDim.y * gridDim.z;
    unsigned sum, cnt, mine, sp = 0u;
    for (;;) {
        sum = 0u; cnt = 0u; mine = 0u;
#pragma unroll
        for (unsigned j = 0; j < 16; ++j) { const unsigned c = xb_ld(&bar[XB_XCNT(j)]); sum += c; cnt += (c > 0u) ? 1u : 0u; mine = (j == x) ? c : mine; }
        if (sum == G) break;
        __builtin_amdgcn_s_sleep(1);
        if ((++sp & 255u) == 0u) { if (xb_ld(&bar[XB_TMO])) break; if (sp > XB_SPIN_CAP) { atomicAdd(&bar[XB_TMO], 1u); break; } }
    }
    nloc = mine > 0u ? mine : 1u; nx = cnt > 0u ? cnt : 1u;
}
__device__ __forceinline__ void xcd_barrier(const XcdBarrier& b) {
    asm volatile("s_waitcnt vmcnt(0)" ::: "memory");
    __syncthreads();
    if (threadIdx.x == 0) {
        unsigned* bar = b.bar;
        __builtin_amdgcn_s_waitcnt(0);
        unsigned nloc = b.st[0], nx = b.st[1];
        if (nloc == 0u) { xcd_barrier_complete(bar, b.x, nloc, nx); b.st[0] = nloc; b.st[1] = nx; }
        const unsigned old = xb_add(&bar[XB_XSUB(b.x)], 1u);
        const unsigned gen = old / nloc;
        if (old + 1u == (gen + 1u) * nloc) {
            __builtin_amdgcn_fence(__ATOMIC_RELEASE, "agent");
            asm volatile("s_waitcnt vmcnt(0)" ::: "memory");
            const unsigned og = xb_add(&bar[XB_TOP], 1u);
            const unsigned tg = og / nx;
            if (og + 1u == (tg + 1u) * nx) xb_add(&bar[XB_TOPGEN], 1u);
            else XB_SPIN(xb_ld(&bar[XB_TOPGEN]) == tg, bar);
            __builtin_amdgcn_fence(__ATOMIC_ACQUIRE, "agent");
            xb_add(&bar[XB_XGEN(b.x)], 1u);
            asm volatile("s_waitcnt vmcnt(0)" ::: "memory");
        } else {
            XB_SPIN(xb_ld(&bar[XB_XGEN(b.x)]) == gen, bar);
            __builtin_amdgcn_fence(__ATOMIC_ACQUIRE, "agent");
            asm volatile("s_waitcnt vmcnt(0)" ::: "memory");
        }
    }
    __syncthreads();
}

constexpr int LDS_MISC = 135168;
constexpr int LDS_BYTES = LDS_MISC + 64;
constexpr int NPHASE = 16;

__global__ void __launch_bounds__(512, 2) fwd_megakernel(Params p_in) {
    extern __shared__ __attribute__((aligned(16))) unsigned char lds_raw[];
    cg::grid_group grid = cg::this_grid();
    { volatile LAS unsigned* st0 = (volatile LAS unsigned*)((LAS unsigned char*)lds_raw + LDS_MISC); if (threadIdx.x < 16) st0[threadIdx.x] = 0u; }
    __syncthreads();
    (void)xcd_barrier_post((unsigned*)(p_in.ws + WS_CTL), (volatile LAS unsigned*)((LAS unsigned char*)lds_raw + LDS_MISC));
#define XBAR() do { XcdBarrier xb_; xb_.bar = (unsigned*)(p_in.ws + WS_CTL); xb_.x = xb_xcc_id(); xb_.st = (volatile LAS unsigned*)((LAS unsigned char*)lds_raw + LDS_MISC); xcd_barrier(xb_); } while (0)
    if (p_in.ph_lo < 0) grid.sync();
    int rep_ = 0;
    int wave_s = __builtin_amdgcn_readfirstlane((int)threadIdx.x >> 6);
    KargPtr kp4 = (KargPtr)__builtin_amdgcn_kernarg_segment_ptr();
    const int ph_hi_ = p_in.ph_hi;
#pragma nounroll
    for (int ph = p_in.ph_lo; ph < ph_hi_; ++ph) {
        asm volatile("" : "+s"(wave_s));
        int lane_ = (int)__builtin_amdgcn_mbcnt_hi(~0u, __builtin_amdgcn_mbcnt_lo(~0u, 0u)); asm volatile("" : "+v"(lane_));
        int tid_ = wave_s * 64 + lane_;
        asm volatile("" : "+s"(kp4));
#if defined(__HIP_DEVICE_COMPILE__)
        const Params p = *kp4;
#else
        const Params p = p_in;
#endif
        int bid_ = blockIdx.x; asm volatile("" : "+s"(bid_));
        unsigned lds0 = 0; asm volatile("" : "+s"(lds0));
        Frame F;
        F.lds = (LAS unsigned char*)lds_raw + lds0;
        F.tid = tid_; F.lane = F.tid & 63; F.wave = __builtin_amdgcn_readfirstlane(F.tid >> 6);
        F.G = gridDim.x; F.bid = bid_;
        const float* MOD = (const float*)(p.ws + WS_MOD);
        bf16_t* H = (bf16_t*)(p.ws + WS_H); bf16_t* ACT = (bf16_t*)(p.ws + WS_ACT); bf16_t* OB = (bf16_t*)(p.ws + WS_OB);
        float* X = p.out;
        if (ph == 0) {
#if !defined(MASK) || ((MASK>>0)&1)
            phase_prologue(p, F);
#endif
        } else {
            const int l = ph == 1 ? 0 : (ph - 2) / 7, k = ph == 1 ? -1 : (ph - 2) % 7;
            const float* modl = MOD + (size_t)l * 81 * 1024;
            unsigned char* wl = p.ws + WS_W + (size_t)l * W_LAYER;
            if (k == 3) {
#if !defined(MASK) || ((MASK>>5)&1)
                phase_mix(p, F, l);
#endif
            } else {
#if !defined(MASK) || ((MASK>>2)&1)
                EpiAll E; E.c0 = ECtx{kp4, l, k, F.lds + 131072};
                pg8::Gemm g; int N;
                if (k == -1) { g = pg8::Gemm{(const bf16_t*)(p.ws + WS_SHB), (const bf16_t*)(p.ws + WS_W), 256, NB, D}; N = NB; }
                else if (k == 0 || k == 5) { g = pg8::Gemm{H, (const bf16_t*)(wl + (k == 0 ? W_GU0 : W_GU1)), M, NGU, D}; N = NGU; }
                else if (k == 4) { g = pg8::Gemm{OB, (const bf16_t*)(wl + W_OUT), M, D, D}; N = D; }
                else if (k == 2) { g = pg8::Gemm{H, (const bf16_t*)(wl + W_IN), M, NIN, D}; N = NIN; }
                else { const int f = k == 1 ? 0 : 1; g = pg8::Gemm{ACT, (const bf16_t*)(wl + W_D + f * W_D_SZ), M, D, FF}; N = D; }
                pg8::StaticOrder S;
                const bool full = F.G == 256;
                if (k == -1) {
                    const int lb = F.bid < 53 ? 0 : 1;
                    g.A = (const bf16_t*)(p.ws + WS_SHB) + (size_t)lb * 256 * 1024; g.Bt = (const bf16_t*)(p.ws + WS_W + (size_t)lb * W_LAYER); E.c0.l = lb;
                    S.init(256, NB, 53, F.bid % 53);
                    if (F.bid >= (full ? 53 : 106)) S.nwg = 0;
                } else {
                    S.init(M, N, F.G, F.bid);
                    if (full && l == 0 && k == 5 && F.bid >= 203) { S.exi = 5; S.expm = -167; S.expn = 48 + (F.bid - 203); }
                }
                pg8::gemm_phase<EpiAll>(F.lds, F.tid, g, S, E);
                if (k == -1) phase_norm0(p, F);
                if (full && l == 0) {
                    if (k == 0 && F.bid >= 128) convert_items(p, F, 0, CV_NA, CV_LAYER, (F.bid - 128) * 8 + F.wave, 128 * 8);
                    if (k == 2 && F.bid >= 64) convert_items(p, F, 1, 0, CV_NA, (F.bid - 64) * 8 + F.wave, 192 * 8);
                    if (k == 5 && F.bid >= 128 && F.bid < 203) convert_items(p, F, 1, CV_NA, CV_LAYER, (F.bid - 128) * 8 + F.wave, 75 * 8);
                }
#endif
            }
        }
#if PROBE_REP
        { const int kind_ = ph < 2 ? ph : 2 + (ph - 2) % 7;
          if (((PROBE_REP >> kind_) & 1) && rep_ == 0) { rep_ = 1; XBAR(); --ph; continue; }
          rep_ = 0; }
#endif
        if (ph + 1 < ph_hi_) XBAR();
    }
    for (int i_ = 0; i_ < PROBE_SYNC; ++i_) XBAR();
}

extern "C" void kernel_launch(void* const* d_in, const int* in_sizes, int n_in, void* d_out, int out_size, void* d_ws, size_t ws_size, hipStream_t stream) {
    static int grid_blocks = 0;
    if (!grid_blocks) {
        int dev = 0, cus = 0, per_cu = 0;
        hipGetDevice(&dev);
        hipDeviceGetAttribute(&cus, hipDeviceAttributeMultiprocessorCount, dev);
        hipFuncSetAttribute((const void*)fwd_megakernel, hipFuncAttributeMaxDynamicSharedMemorySize, LDS_BYTES);
        hipOccupancyMaxActiveBlocksPerMultiprocessor(&per_cu, (const void*)fwd_megakernel, 512, LDS_BYTES);
        if (per_cu < 1) { fprintf(stderr, "kernel_launch: occupancy query reports %d blocks per CU\n", per_cu); per_cu = 1; }
        grid_blocks = cus;
        (void)hipGetLastError();
    }
    Params p{};
    const float** pp = (const float**)&p;
    for (int i = 0; i < 23; ++i) pp[i] = (const float*)d_in[i];
    p.out = (float*)d_out; p.ws = (unsigned char*)d_ws;
    p.ph_lo = 0; p.ph_hi = NPHASE;
    (void)hipMemsetAsync((unsigned char*)d_ws + WS_CTL, 0, CTL_BYTES, stream);
    void* args[] = {&p};
    hipError_t e = hipLaunchCooperativeKernel((const void*)fwd_megakernel, dim3(grid_blocks), dim3(512), args, LDS_BYTES, stream);
    if (e != hipSuccess) fprintf(stderr, "cooperative launch failed: %s (grid %d)\n", hipGetErrorString(e), grid_blocks);
}
```
